# Optimizing an MI355X kernel written in HIP

```python
import jax, jax.numpy as jnp
from jax import lax
import numpy as np

D_MODEL = 1024
BATCH = 4
SEQ = 4096
DEPTH = 1
DEC_BATCH = 128
DEC_SEQ = 4
PAST_LEN = 8192
PAGE_SIZE = 128

N_HEADS = 8
HEAD_DIM = 64
D_ATT = N_HEADS * HEAD_DIM
D_LRU = D_MODEL // 2
LRU_BLOCKS = 8
LRU_BLOCK_DIM = D_LRU // LRU_BLOCKS
D_MIX = D_ATT + D_LRU
D_IN = 4 * D_ATT + 2 * D_LRU
CONV_WIDTH = 4
LRU_C = 8.0
DIL_PATTERNS = ((128, 1), (512, 4), (2048, 16))
N_DIL_KEYS = 128
ATT_WINDOW_MAX = 2048
BAND_BLOCK = 128
ALPHA = (2.0 * DEPTH) ** 0.25
BETA = (8.0 * DEPTH) ** -0.25
LN_EPS = 1e-5
NEG_INF = -1e30

kernel_name = "hymba_dilated_attn_rglru_deepnorm_step"


def _project(x, w_in):
    h = jnp.einsum('btd,de->bte', x, w_in)
    cuts = [D_ATT, 2 * D_ATT, 3 * D_ATT, 4 * D_ATT, 4 * D_ATT + D_LRU]
    return jnp.split(h, cuts, axis=-1)


def _band_attention(q, k, v):
    n, l, h, dh = q.shape
    nb = -(-l // BAND_BLOCK)
    pad = nb * BAND_BLOCK - l
    padw = ((0, 0), (0, pad), (0, 0), (0, 0))
    qb = jnp.pad(q, padw).reshape(n, nb, BAND_BLOCK, h, dh)
    kb = jnp.pad(k, padw).reshape(n, nb, BAND_BLOCK, h, dh)
    vb = jnp.pad(v, padw).reshape(n, nb, BAND_BLOCK, h, dh)
    prev = ((0, 0), (1, 0), (0, 0), (0, 0), (0, 0))
    kc = jnp.concatenate([jnp.pad(kb, prev)[:, :-1], kb], axis=2)
    vc = jnp.concatenate([jnp.pad(vb, prev)[:, :-1], vb], axis=2)
    s = jnp.einsum('nbqhd,nbkhd->nbhqk', qb, kc) * (dh ** -0.5)
    qi = jnp.arange(BAND_BLOCK)[:, None]
    ki = jnp.arange(2 * BAND_BLOCK)[None, :]
    dist = qi + BAND_BLOCK - ki
    key_pos = jnp.arange(nb)[:, None, None] * BAND_BLOCK + ki[None] - BAND_BLOCK
    valid = (dist >= 0) & (dist <= N_DIL_KEYS) & (key_pos >= 0)
    s = jnp.where(valid[None, :, None], s, NEG_INF)
    m = s.max(-1)
    p = jnp.exp(s - m[..., None])
    den = p.sum(-1)
    o = jnp.einsum('nbhqk,nbkhd->nbqhd', p, vc) / den.transpose(0, 1, 3, 2)[..., None]
    o = o.reshape(n, nb * BAND_BLOCK, h, dh)[:, :l]
    m = m.transpose(0, 1, 3, 2).reshape(n, nb * BAND_BLOCK, h)[:, :l]
    den = den.transpose(0, 1, 3, 2).reshape(n, nb * BAND_BLOCK, h)[:, :l]
    return o, m, den


def _dilated_prompt(q, k, v, d):
    b, s, h, dh = q.shape
    l = s // d

    def sub(t):
        return t.reshape(b, l, d, h, dh).transpose(0, 2, 1, 3, 4).reshape(b * d, l, h, dh)

    o, m, den = _band_attention(sub(q), sub(k), sub(v))
    o = o.reshape(b, d, l, h, dh).transpose(0, 2, 1, 3, 4).reshape(b, s, h, dh)
    m = m.reshape(b, d, l, h).transpose(0, 2, 1, 3).reshape(b, s, h)
    den = den.reshape(b, d, l, h).transpose(0, 2, 1, 3).reshape(b, s, h)
    return o, m, den


def _dilated_sample(q, k_all, v_all, d):
    t = q.shape[1]
    w_buf = k_all.shape[1] - t
    idx = w_buf + jnp.arange(t)[:, None] - d * jnp.arange(N_DIL_KEYS + 1)[None, :]
    valid = idx >= 0
    idx = jnp.maximum(idx, 0)
    kg = jnp.take(k_all, idx, axis=1)
    vg = jnp.take(v_all, idx, axis=1)
    s = jnp.einsum('bqhd,bqjhd->bhqj', q, kg) * (q.shape[-1] ** -0.5)
    s = jnp.where(valid[None, None], s, NEG_INF)
    m = s.max(-1)
    p = jnp.exp(s - m[..., None])
    den = p.sum(-1)
    o = jnp.einsum('bhqj,bqjhd->bqhd', p, vg) / den.transpose(0, 2, 1)[..., None]
    return o, m.transpose(0, 2, 1), den.transpose(0, 2, 1)


def _merge(parts):
    m_max = jnp.max(jnp.stack([p[1] for p in parts]), axis=0)
    ws = [den * jnp.exp(m - m_max) for (_, m, den) in parts]
    total = sum(ws)
    return sum(w[..., None] * o for w, (o, _, _) in zip(ws, parts)) / total[..., None]


def _lin_combine(e1, e2):
    a1, b1 = e1
    a2, b2 = e2
    return a1 * a2, a2 * b1 + b2


def _lru_branch(xl, conv_state, h0, conv_w, conv_b, w_ra, b_ra, w_ri, b_ri, lru_lambda):
    b, t, _ = xl.shape
    xc = jnp.concatenate([conv_state.astype(xl.dtype), xl], axis=1)
    u = conv_b + sum(xc[:, w:w + t] * conv_w[w] for w in range(CONV_WIDTH))
    new_conv = xc[:, t:]
    u32 = u.astype(jnp.float32)
    ub = u32.reshape(b, t, LRU_BLOCKS, LRU_BLOCK_DIM)
    r = jax.nn.sigmoid(jnp.einsum('bthi,hij->bthj', ub, w_ra.astype(jnp.float32)).reshape(b, t, D_LRU)
                       + b_ra.astype(jnp.float32))
    ig = jax.nn.sigmoid(jnp.einsum('bthi,hij->bthj', ub, w_ri.astype(jnp.float32)).reshape(b, t, D_LRU)
                        + b_ri.astype(jnp.float32))
    log_a = -LRU_C * r * jax.nn.softplus(-lru_lambda.astype(jnp.float32))
    a = jnp.exp(log_a)
    bx = jnp.sqrt(-jnp.expm1(2.0 * log_a)) * ig * u32
    bx = bx.at[:, 0].add(a[:, 0] * h0.astype(jnp.float32))
    _, h = lax.associative_scan(_lin_combine, (a, bx), axis=1)
    return h, new_conv, h[:, -1]


def _finish(x, y_att, g_att, h_lru, g_lru, w_out, ln_g, ln_b):
    mixed = jnp.concatenate([y_att * jax.nn.silu(g_att.astype(jnp.float32)),
                             h_lru * jax.nn.silu(g_lru.astype(jnp.float32))], axis=-1)
    sub = jnp.einsum('bte,ed->btd', mixed, w_out.astype(jnp.float32))
    z = ALPHA * x.astype(jnp.float32) + sub
    mu = z.mean(-1, keepdims=True)
    var = jnp.square(z - mu).mean(-1, keepdims=True)
    zn = (z - mu) * lax.rsqrt(var + LN_EPS)
    return (zn * ln_g.astype(jnp.float32) + ln_b.astype(jnp.float32)).astype(x.dtype)


def _layer(x_p, x_s, ck, cv, sc, sh, w_in, conv_w, conv_b, w_ra, b_ra, w_ri, b_ri, lru_lambda,
           w_out, ln_g, ln_b):
    f32 = jnp.float32
    b, s, _ = x_p.shape
    q, k, v, ga, xl, gl = _project(x_p, w_in)
    qh, kh, vh = (t_.reshape(b, s, N_HEADS, HEAD_DIM) for t_ in (q, k, v))
    y_att = _merge([_dilated_prompt(qh.astype(f32), kh.astype(f32), vh.astype(f32), d)
                    for _, d in DIL_PATTERNS]).reshape(b, s, D_ATT)
    h_lru, conv_p, h_p = _lru_branch(xl, jnp.zeros((b, CONV_WIDTH - 1, D_LRU), xl.dtype),
                                     jnp.zeros((b, D_LRU), f32), conv_w, conv_b, w_ra, b_ra,
                                     w_ri, b_ri, lru_lambda)
    y_p = _finish(x_p, y_att, ga, h_lru, gl, w_out, ln_g, ln_b)
    n_keep = min(ATT_WINDOW_MAX, s)
    k_p, v_p = kh[:, s - n_keep:], vh[:, s - n_keep:]
    bs, t, _ = x_s.shape
    q2, k2, v2, ga2, xl2, gl2 = _project(x_s, w_in)
    qh2, kh2, vh2 = (t_.reshape(bs, t, N_HEADS, HEAD_DIM) for t_ in (q2, k2, v2))
    k_all = jnp.concatenate([ck.astype(f32), kh2.astype(f32)], axis=1)
    v_all = jnp.concatenate([cv.astype(f32), vh2.astype(f32)], axis=1)
    y_att2 = _merge([_dilated_sample(qh2.astype(f32), k_all, v_all, d)
                     for _, d in DIL_PATTERNS]).reshape(bs, t, D_ATT)
    h_lru2, conv_s, h_s = _lru_branch(xl2, sc, sh, conv_w, conv_b, w_ra, b_ra, w_ri, b_ri, lru_lambda)
    y_s = _finish(x_s, y_att2, ga2, h_lru2, gl2, w_out, ln_g, ln_b)
    return y_p, y_s, k_p, v_p, conv_p, h_p, kh2, vh2, conv_s, h_s


def setup_inputs(seed: int = 0) -> dict:
    key = jax.random.key(seed)
    ks = jax.random.split(key, 17)
    w_buf = min(ATT_WINDOW_MAX, PAST_LEN)
    nrm = jax.random.normal
    col_scale = jnp.concatenate([jnp.ones((2 * D_ATT,)), jnp.full((D_ATT,), BETA), jnp.ones((D_ATT,)),
                                 jnp.full((D_LRU,), BETA), jnp.ones((D_LRU,))]).astype(jnp.float32)
    u = jax.random.uniform(ks[12], (DEPTH, D_LRU), minval=0.9, maxval=0.999)
    a_base = u ** (1.0 / LRU_C)
    return {
        "x_prompt": nrm(ks[0], (BATCH, SEQ, D_MODEL), jnp.float32),
        "x_sample": nrm(ks[1], (DEC_BATCH, DEC_SEQ, D_MODEL), jnp.float32),
        "cache_k": nrm(ks[2], (DEPTH, DEC_BATCH, w_buf, N_HEADS, HEAD_DIM), jnp.float32),
        "cache_v": nrm(ks[3], (DEPTH, DEC_BATCH, w_buf, N_HEADS, HEAD_DIM), jnp.float32) * BETA,
        "state_conv": nrm(ks[4], (DEPTH, DEC_BATCH, CONV_WIDTH - 1, D_LRU), jnp.float32) * BETA,
        "state_h": nrm(ks[5], (DEPTH, DEC_BATCH, D_LRU), jnp.float32) * 0.5,
        "w_in": nrm(ks[6], (DEPTH, D_MODEL, D_IN), jnp.float32) * (D_MODEL ** -0.5) * col_scale,
        "conv_w": nrm(ks[7], (DEPTH, CONV_WIDTH, D_LRU), jnp.float32) * (CONV_WIDTH ** -0.5),
        "conv_b": nrm(ks[8], (DEPTH, D_LRU), jnp.float32) * 0.01,
        "w_ra": nrm(ks[9], (DEPTH, LRU_BLOCKS, LRU_BLOCK_DIM, LRU_BLOCK_DIM), jnp.float32) * (LRU_BLOCK_DIM ** -0.5),
        "b_ra": nrm(ks[10], (DEPTH, D_LRU), jnp.float32) * 0.01,
        "w_ri": nrm(ks[11], (DEPTH, LRU_BLOCKS, LRU_BLOCK_DIM, LRU_BLOCK_DIM), jnp.float32) * (LRU_BLOCK_DIM ** -0.5),
        "b_ri": nrm(ks[13], (DEPTH, D_LRU), jnp.float32) * 0.01,
        "lru_lambda": jnp.log(a_base) - jnp.log1p(-a_base),
        "w_out": nrm(ks[14], (DEPTH, D_MIX, D_MODEL), jnp.float32) * (D_MIX ** -0.5) * BETA,
        "ln_g": 1.0 + 0.02 * nrm(ks[15], (DEPTH, D_MODEL), jnp.float32),
        "ln_b": 0.02 * nrm(ks[16], (DEPTH, D_MODEL), jnp.float32),
    }


def reference(x_prompt, x_sample, cache_k, cache_v, state_conv, state_h, w_in, conv_w, conv_b,
              w_ra, b_ra, w_ri, b_ri, lru_lambda, w_out, ln_g, ln_b):
    xp, xs = x_prompt, x_sample
    kp_l, vp_l, cp_l, hp_l, ks_l, vs_l, cs_l, hs_l = [], [], [], [], [], [], [], []
    for l in range(DEPTH):
        xp, xs, kp, vp, cp, hp, ks_, vs_, cs, hs = _layer(
            xp, xs, cache_k[l], cache_v[l], state_conv[l], state_h[l], w_in[l], conv_w[l], conv_b[l],
            w_ra[l], b_ra[l], w_ri[l], b_ri[l], lru_lambda[l], w_out[l], ln_g[l], ln_b[l])
        kp_l.append(kp); vp_l.append(vp); cp_l.append(cp); hp_l.append(hp)
        ks_l.append(ks_); vs_l.append(vs_); cs_l.append(cs); hs_l.append(hs)
    return (xp, xs, jnp.stack(kp_l), jnp.stack(vp_l), jnp.stack(cp_l), jnp.stack(hp_l),
            jnp.stack(ks_l), jnp.stack(vs_l), jnp.stack(cs_l), jnp.stack(hs_l))
```

```cpp
#include <hip/hip_runtime.h>
#include <cstdio>
#include <cstdint>
namespace pg8 {
#define PG8_LAS __attribute__((address_space(3)))
typedef unsigned short bf16_t;
typedef short bf16x8 __attribute__((ext_vector_type(8)));
typedef float f32x4 __attribute__((ext_vector_type(4)));
typedef unsigned u32x4 __attribute__((ext_vector_type(4)));
constexpr int BM = 256, BK = 64, HALF = 128, HTB = HALF * BK * 2  , STAGE_BYTES = 8 * HTB, NXCD = 8, WGM = 8;

__host__ __device__ __forceinline__ int lds_byte(int r, int c) { const int st = (r >> 4) * 2 + (c >> 5), rr = r & 15, cc = c & 31, ob = rr * 64 + cc * 2; return st * 1024 + (ob ^ (((ob >> 9) & 1) << 5)); }
__host__ __device__ __forceinline__ void stage_rc(int b, int& R, int& C) { const int st = b / 1024, sb = b % 1024, swz = sb ^ (((sb >> 9) & 1) << 5); R = (st >> 1) * 16 + swz / 64; C = (st & 1) * 32 + (swz % 64) / 2; }
__host__ __device__ __forceinline__ int perm32(int rho) { const int n = rho >> 4, i = rho & 15; return 8 * (i >> 2) + 4 * n + (i & 3); }

struct Unit { int pm, pn; };
struct Gemm { const bf16_t* A; const bf16_t* Bt; int M, N, K; };

struct StaticOrder {
    int nM, nN, nwg, G, c;
    __host__ __device__ void init(int M, int N, int G_, int c_) { nM = M / BM; nN = N / BM; nwg = nM * nN; G = G_; c = c_; }
    __host__ __device__ bool next(int i, Unit& u) const {
        const long L = (long)i * G + c; if (L >= nwg) return false;
        int wgid = (int)L; { const int q = nwg / NXCD, r = nwg % NXCD, xcd = wgid % NXCD, off = wgid / NXCD; wgid = (xcd < r ? xcd * (q + 1) : r * (q + 1) + (xcd - r) * q) + off; }
        const int nig = WGM * nN, gid = wgid / nig, fm = gid * WGM, gsz = (nM - fm) < WGM ? (nM - fm) : WGM;
        u.pm = fm + ((wgid % nig) % gsz); u.pn = (wgid % nig) / gsz; return true;
    }
    __device__ __forceinline__ void a_ready(const Unit&) const {}
    __device__ __forceinline__ void done(const Unit&) const {}
};

__device__ __forceinline__ unsigned cvt_pk_bf16(float lo, float hi) { unsigned r; asm volatile("v_cvt_pk_bf16_f32 %0, %1, %2" : "=v"(r) : "v"(lo), "v"(hi)); return r; }
typedef float f32x2 __attribute__((ext_vector_type(2)));
__device__ __forceinline__ f32x2 gelu_pk(f32x2 v) {
    const f32x2 av = __builtin_elementwise_abs(v), d = av * 0.2316418882f + 1.0f;
    f32x2 t; t.x = __builtin_amdgcn_rcpf(d.x); t.y = __builtin_amdgcn_rcpf(d.y);
    f32x2 q = t * 0.5307027145f + (-0.7265760135f); q = q * t + 0.7107068705f; q = q * t + (-0.142248368f); q = q * t + 0.127414796f; q = q * t;
    const f32x2 s = (v * v) * (-0.72134752044f);
    f32x2 e; e.x = __builtin_amdgcn_exp2f(s.x); e.y = __builtin_amdgcn_exp2f(s.y);
    const f32x2 m = v * (q * e), r = v - m;
    f32x2 o; o.x = v.x < 0.f ? m.x : r.x; o.y = v.y < 0.f ? m.y : r.y; return o;
}

template <int ACT  > struct EpiBf16 {
    static constexpr bool PERM = true, AFTER_DRAIN = false; static_assert(ACT == 0 || ACT == 1, "EpiBf16: ACT is 0 (none) or 1 (gelu_pk)");
    bf16_t* O; int ldc; const float* bias; int split_cols; size_t split_stride; float scale0;
    __device__ __forceinline__ void operator()(const f32x4 (&acc)[2][2][4][2], const Unit& u, int wr, int wc, int fr, int fq) const {
        const int row0 = u.pm * BM + wr * 64 + fr; int colt = u.pn * BM; bf16_t* base = O;
        float sc = 1.f; if (split_cols) { const int t = colt / split_cols; base += (size_t)t * split_stride; colt -= t * split_cols; if (t == 0) sc = scale0; }
        const int col0 = colt + wc * 32 + 8 * fq, bcol0 = u.pn * BM + wc * 32 + 8 * fq;
        f32x4 bv[2][2];
#pragma unroll
        for (int bj = 0; bj < 2; ++bj)
#pragma unroll
            for (int n = 0; n < 2; ++n) bv[bj][n] = bias ? *(const f32x4*)(bias + bcol0 + bj * HALF + 4 * n) : (f32x4){0.f, 0.f, 0.f, 0.f};
#pragma unroll
        for (int ai = 0; ai < 2; ++ai)
#pragma unroll
            for (int m = 0; m < 4; ++m) { bf16_t* rowp = base + (size_t)(row0 + ai * HALF + m * 16) * ldc + col0;
#pragma unroll
                for (int bj = 0; bj < 2; ++bj) { f32x4 v0 = acc[ai][bj][m][0] + bv[bj][0], v1 = acc[ai][bj][m][1] + bv[bj][1];
                    if (ACT == 1) { f32x2 a = gelu_pk((f32x2){v0[0], v0[1]}), b = gelu_pk((f32x2){v0[2], v0[3]}), c = gelu_pk((f32x2){v1[0], v1[1]}), d = gelu_pk((f32x2){v1[2], v1[3]});
                        v0 = (f32x4){a.x, a.y, b.x, b.y}; v1 = (f32x4){c.x, c.y, d.x, d.y}; }
                    v0 = v0 * sc; v1 = v1 * sc; u32x4 w; w.x = cvt_pk_bf16(v0[0], v0[1]); w.y = cvt_pk_bf16(v0[2], v0[3]); w.z = cvt_pk_bf16(v1[0], v1[1]); w.w = cvt_pk_bf16(v1[2], v1[3]);
                    *(u32x4*)(rowp + bj * HALF) = w; } }
    }
};

struct PanelStats {
    unsigned* xbuf;
    unsigned* cnt;
    unsigned* tmo;
    int ntn; float eps;
    unsigned code;
    __device__ __forceinline__ bool run(const f32x4 (&v)[2][2][4][2], const Unit& u, int wr, int wc, int fr, int fq, PG8_LAS unsigned char* lds, int wid, int lane) const {
        typedef float f32x2v __attribute__((ext_vector_type(2)));
        PG8_LAS f32x2v* P = (PG8_LAS f32x2v*)lds;
        PG8_LAS f32x2v* S = (PG8_LAS f32x2v*)(lds + 8192);
        PG8_LAS unsigned* flag = (PG8_LAS unsigned*)(lds + 8192 + 2048);
#pragma unroll
        for (int ai = 0; ai < 2; ++ai)
#pragma unroll
            for (int m = 0; m < 4; ++m) {
                float s = 0.f;
#pragma unroll
                for (int bj = 0; bj < 2; ++bj)
#pragma unroll
                    for (int n = 0; n < 2; ++n) { const f32x4 x = v[ai][bj][m][n]; s += (x[0] + x[1]) + (x[2] + x[3]); }
                s += __shfl_xor(s, 16); s += __shfl_xor(s, 32);
                const float mw = s * (1.0f / 64.0f); float q = 0.f;
#pragma unroll
                for (int bj = 0; bj < 2; ++bj)
#pragma unroll
                    for (int n = 0; n < 2; ++n) { const f32x4 d = v[ai][bj][m][n] - mw; q += (d[0] * d[0] + d[1] * d[1]) + (d[2] * d[2] + d[3] * d[3]); }
                q += __shfl_xor(q, 16); q += __shfl_xor(q, 32);
                if (fq == 0) P[(ai * HALF + wr * 64 + m * 16 + fr) * 4 + wc] = (f32x2v){mw, q};
            }
        asm volatile("s_waitcnt lgkmcnt(0)" ::: "memory"); __builtin_amdgcn_s_barrier(); asm volatile("" ::: "memory");
#if defined(BROKEN_EXCHANGE_NO_WAIT)
#warning BROKEN CONTROL BUILD: the row-statistics exchange does not wait; results are wrong by design
        if (blockIdx.x >= 64) { const long long t0_ = clock64(); while (clock64() - t0_ < 60000) __builtin_amdgcn_s_sleep(8); }
#endif
        const int row = wid * 32 + (lane & 31);
        if (lane < 32) {
            const f32x2v a = P[row * 4 + 0], b = P[row * 4 + 1], c = P[row * 4 + 2], d = P[row * 4 + 3];
            const float mt = (a.x + b.x + c.x + d.x) * 0.25f;
            const float da = a.x - mt, db = b.x - mt, dc = c.x - mt, dd = d.x - mt;
            const float m2 = (a.y + b.y) + (c.y + d.y) + 64.0f * ((da * da + db * db) + (dc * dc + dd * dd));
            unsigned long long* slot = (unsigned long long*)xbuf + ((size_t)(u.pm * BM + row) * 4 + u.pn);
            __hip_atomic_store(slot, ((unsigned long long)__float_as_uint(m2) << 32) | __float_as_uint(mt), __ATOMIC_RELAXED, __HIP_MEMORY_SCOPE_AGENT);
        }
        asm volatile("s_waitcnt vmcnt(0)" ::: "memory");
        if (lane == 0) __hip_atomic_fetch_add(cnt + 64 * u.pm, 1u, __ATOMIC_RELAXED, __HIP_MEMORY_SCOPE_AGENT);
        if (wid == 0) {
            bool dead = false; const unsigned long long t0 = __builtin_amdgcn_s_memrealtime(); const unsigned want = 8u * (unsigned)ntn;
            for (;;) {
#if defined(BROKEN_EXCHANGE_NO_WAIT)
                break;
#endif
                if ((unsigned)__builtin_amdgcn_readfirstlane(__hip_atomic_load(cnt + 64 * u.pm, __ATOMIC_RELAXED, __HIP_MEMORY_SCOPE_AGENT)) >= want) break;
                if (__builtin_amdgcn_s_memrealtime() - t0 > 2000000ull) {
                    if (lane == 0) { unsigned expect = 0u; __hip_atomic_compare_exchange_strong(tmo + 1, &expect, code | (unsigned)(u.pm & 0xff), __ATOMIC_RELAXED, __ATOMIC_RELAXED, __HIP_MEMORY_SCOPE_AGENT);
                                     __hip_atomic_store(tmo, 1u, __ATOMIC_RELAXED, __HIP_MEMORY_SCOPE_AGENT); }
                    dead = true; break; }
                __builtin_amdgcn_s_sleep(2);
            }
            __builtin_amdgcn_fence(__ATOMIC_ACQUIRE, "agent");
            if (lane == 0) flag[0] = dead ? 1u : 0u;
        }
        asm volatile("s_waitcnt vmcnt(0) lgkmcnt(0)" ::: "memory"); __builtin_amdgcn_s_barrier(); asm volatile("" ::: "memory");
        const bool bad = flag[0] != 0u;
        if (lane < 32) {
            const unsigned long long* slot = (const unsigned long long*)xbuf + (size_t)(u.pm * BM + row) * 4; float mt[4], m2[4]; float ms = 0.f;
#pragma unroll
            for (int t = 0; t < 4; ++t) { if (t < ntn) { const unsigned long long w = __hip_atomic_load(slot + t, __ATOMIC_RELAXED, __HIP_MEMORY_SCOPE_AGENT); mt[t] = __uint_as_float((unsigned)w); m2[t] = __uint_as_float((unsigned)(w >> 32)); } else { mt[t] = 0.f; m2[t] = 0.f; } ms += mt[t]; }
            const float mean = ms / (float)ntn; float q = 0.f;
#pragma unroll
            for (int t = 0; t < 4; ++t) if (t < ntn) { const float dm = mt[t] - mean; q += m2[t] + 256.0f * dm * dm; }
            S[row] = (f32x2v){mean, 1.0f / sqrtf(q / (256.0f * (float)ntn) + eps)};
        }
        asm volatile("s_waitcnt lgkmcnt(0)" ::: "memory"); __builtin_amdgcn_s_barrier(); asm volatile("" ::: "memory");
        return bad;
    }
};
struct EpiLnRes {
    static constexpr bool PERM = false, AFTER_DRAIN = true;
    const float* base; float* out; int ldc; const float* bias; PanelStats st; unsigned poison;
    __device__ __forceinline__ void fused(f32x4 (&acc)[2][2][4][2], const Unit& u, int wr, int wc, int fr, int fq, PG8_LAS unsigned char* lds, int wid, int lane) const {
        typedef float f32x2v __attribute__((ext_vector_type(2)));
        const PG8_LAS f32x2v* S = (const PG8_LAS f32x2v*)(lds + 8192);
        const int col0 = u.pn * BM + wc * 32 + 4 * fq;
#pragma unroll
        for (int bj = 0; bj < 2; ++bj)
#pragma unroll
            for (int n = 0; n < 2; ++n) { const f32x4 bv = bias ? *(const f32x4*)(bias + col0 + bj * HALF + n * 16) : (f32x4){0.f, 0.f, 0.f, 0.f};
#pragma unroll
                for (int ai = 0; ai < 2; ++ai)
#pragma unroll
                    for (int m = 0; m < 4; ++m) acc[ai][bj][m][n] += bv; }
        f32x4 pre[4][2][2];
#pragma unroll
        for (int m = 0; m < 4; ++m) { const size_t off = (size_t)(u.pm * BM + wr * 64 + m * 16 + fr) * ldc + col0;
#pragma unroll
            for (int bj = 0; bj < 2; ++bj)
#pragma unroll
                for (int n = 0; n < 2; ++n) pre[m][bj][n] = *(const f32x4*)(base + off + bj * HALF + n * 16); }
        const bool bad = st.run(acc, u, wr, wc, fr, fq, lds, wid, lane) || poison != 0u;
        const float qnan = __builtin_nanf("");
#pragma unroll
        for (int ai = 0; ai < 2; ++ai)
#pragma unroll
            for (int m = 0; m < 4; ++m) { const int r = ai * HALF + wr * 64 + m * 16 + fr; const f32x2v sr = S[r]; const size_t off = (size_t)(u.pm * BM + r) * ldc + col0;
#pragma unroll
                for (int bj = 0; bj < 2; ++bj)
#pragma unroll
                    for (int n = 0; n < 2; ++n) { const f32x4 bs = ai == 0 ? pre[m][bj][n] : *(const f32x4*)(base + off + bj * HALF + n * 16); f32x4 o = bs + (acc[ai][bj][m][n] - sr.x) * sr.y;
                        if (bad) o = (f32x4){qnan, qnan, qnan, qnan}; *(f32x4*)(out + off + bj * HALF + n * 16) = o; }
                if (m & 1) asm volatile("" ::: "memory"); }
    }
};
struct EpiLnResLn {
    static constexpr bool PERM = false, AFTER_DRAIN = true;
    const float* base; float* out; bf16_t* xn; int ldc; const float* bias; PanelStats st1, st2; unsigned poison;
    __device__ __forceinline__ void fused(f32x4 (&acc)[2][2][4][2], const Unit& u, int wr, int wc, int fr, int fq, PG8_LAS unsigned char* lds, int wid, int lane) const {
        typedef float f32x2v __attribute__((ext_vector_type(2))); typedef unsigned u32x2v __attribute__((ext_vector_type(2)));
        const PG8_LAS f32x2v* S = (const PG8_LAS f32x2v*)(lds + 8192);
        const int col0 = u.pn * BM + wc * 32 + 4 * fq;
#pragma unroll
        for (int bj = 0; bj < 2; ++bj)
#pragma unroll
            for (int n = 0; n < 2; ++n) { const f32x4 bv = bias ? *(const f32x4*)(bias + col0 + bj * HALF + n * 16) : (f32x4){0.f, 0.f, 0.f, 0.f};
#pragma unroll
                for (int ai = 0; ai < 2; ++ai)
#pragma unroll
                    for (int m = 0; m < 4; ++m) acc[ai][bj][m][n] += bv; }
        bool bad = st1.run(acc, u, wr, wc, fr, fq, lds, wid, lane) || poison != 0u;
        const float qnan = __builtin_nanf("");
#pragma unroll
        for (int ai = 0; ai < 2; ++ai)
#pragma unroll
            for (int m = 0; m < 4; ++m) { const int r = ai * HALF + wr * 64 + m * 16 + fr; const f32x2v sr = S[r]; const size_t off = (size_t)(u.pm * BM + r) * ldc + col0;
#pragma unroll
                for (int bj = 0; bj < 2; ++bj)
#pragma unroll
                    for (int n = 0; n < 2; ++n) { const f32x4 bs = *(const f32x4*)(base + off + bj * HALF + n * 16); acc[ai][bj][m][n] = bs + (acc[ai][bj][m][n] - sr.x) * sr.y; }
                asm volatile("" : "+v"(acc[ai][0][m][0]), "+v"(acc[ai][0][m][1]), "+v"(acc[ai][1][m][0]), "+v"(acc[ai][1][m][1]));
                if (m & 1) asm volatile("" ::: "memory"); }
        const bool bad1 = bad;
        bad = st2.run(acc, u, wr, wc, fr, fq, lds, wid, lane) || bad;
#pragma unroll
        for (int ai = 0; ai < 2; ++ai)
#pragma unroll
            for (int m = 0; m < 4; ++m) { const int r = ai * HALF + wr * 64 + m * 16 + fr; const f32x2v sr = S[r]; const size_t off = (size_t)(u.pm * BM + r) * ldc + col0;
#pragma unroll
                for (int bj = 0; bj < 2; ++bj)
#pragma unroll
                    for (int n = 0; n < 2; ++n) { const f32x4 x1 = acc[ai][bj][m][n]; *(f32x4*)(out + off + bj * HALF + n * 16) = bad1 ? (f32x4){qnan, qnan, qnan, qnan} : x1;
                        const f32x4 o = (x1 - sr.x) * sr.y; u32x2v w; w.x = cvt_pk_bf16(o[0], o[1]); w.y = cvt_pk_bf16(o[2], o[3]);
                        if (bad) { w.x = 0x7fc07fc0u; w.y = 0x7fc07fc0u; } *(u32x2v*)(xn + off + bj * HALF + n * 16) = w; }
                asm volatile("" ::: "memory"); }
    }
};

template <class Epi, class Sched, bool ALIGN_EPI = false, bool SP2 = false>
__device__ __forceinline__ void gemm_phase(PG8_LAS unsigned char* lds, const Gemm g, const Sched& S, const Epi& E) {
    int tid_ = threadIdx.x; asm volatile("" : "+v"(tid_));
    const int tid = tid_, wid = __builtin_amdgcn_readfirstlane(tid >> 6), lane = tid & 63, wr = wid >> 2, wc = wid & 3, fr = lane & 15, fq = lane >> 4;
    const int K = g.K, nt = K / BK;
    unsigned voffA[2], voffB[2];
#pragma unroll
    for (int i = 0; i < 2; ++i) { int R, C; stage_rc(tid * 16 + i * 8192, R, C); const int Rb = Epi::PERM ? ((R & ~31) + perm32(R & 31)) : R;
        voffA[i] = (unsigned)(R * K + C) * 2u; voffB[i] = (unsigned)(Rb * K + C) * 2u; }
    const size_t kstep = (size_t)(BK * 2);
    const size_t hstep = (size_t)HALF * K * 2;
    const size_t tstep = 2 * hstep;
    const unsigned ldsw = (unsigned)wid * 1024u;
    const int aoff = lds_byte(wr * 64 + fr, fq * 8), boff = lds_byte(wc * 32 + fr, fq * 8);
#define PG8_SA(b, h) (((b) * 2 + (h)) * HTB)
#define PG8_SB(b, h) ((4 + (b) * 2 + (h)) * HTB)
#define PG8_STAGE(bufoff, gbase, voff) do { _Pragma("unroll") for (int _i = 0; _i < 2; ++_i) \
        __builtin_amdgcn_global_load_lds((const unsigned*)((const char*)(gbase) + (voff)[_i]), (PG8_LAS unsigned*)(lds + (bufoff) + ldsw + _i * 8192), 16, 0, 0); } while (0)
#define PG8_LDA(dst, b, h) do { _Pragma("unroll") for (int m = 0; m < 4; ++m) _Pragma("unroll") for (int k = 0; k < 2; ++k) dst[m][k] = *(const PG8_LAS bf16x8*)(lds + PG8_SA(b, h) + aoff + m * 2048 + k * 1024); } while (0)
#define PG8_LDB(dst, b, h) do { _Pragma("unroll") for (int n = 0; n < 2; ++n) _Pragma("unroll") for (int k = 0; k < 2; ++k) dst[n][k] = *(const PG8_LAS bf16x8*)(lds + PG8_SB(b, h) + boff + n * 2048 + k * 1024); } while (0)
#define PG8_MMA(ai, bj, At, Bt) do { __builtin_amdgcn_s_setprio(1); _Pragma("unroll") for (int m = 0; m < 4; ++m) _Pragma("unroll") for (int n = 0; n < 2; ++n) _Pragma("unroll") for (int k = 0; k < 2; ++k) \
        acc[ai][bj][m][n] = __builtin_amdgcn_mfma_f32_16x16x32_bf16(Bt[n][k], At[m][k], acc[ai][bj][m][n], 0, 0, 0); __builtin_amdgcn_s_setprio(0); } while (0)
#define PG8_WAIT_V(n) asm volatile("s_waitcnt vmcnt(" #n ")" ::: "memory")
#define PG8_WAIT_L(n) asm volatile("s_waitcnt lgkmcnt(" #n ")" ::: "memory")
#define PG8_BAR __builtin_amdgcn_s_barrier()
#define PG8_SCHED __builtin_amdgcn_sched_barrier(0)
    Unit cur, nxt; int ui = 0;
    if (!S.next(0, cur)) return;
    f32x4 acc[2][2][4][2];
#pragma unroll
    for (int a = 0; a < 2; ++a)
#pragma unroll
        for (int b = 0; b < 2; ++b)
#pragma unroll
            for (int m = 0; m < 4; ++m)
#pragma unroll
                for (int n = 0; n < 2; ++n) acc[a][b][m][n] = (f32x4){0.f, 0.f, 0.f, 0.f};
    bf16x8 At[4][2], B0[2][2], B1[2][2];
    const char* cA = (const char*)g.A + (size_t)cur.pm * tstep; const char* cB = (const char*)g.Bt + (size_t)cur.pn * tstep;
    S.a_ready(cur);
    if constexpr (SP2) {
        PG8_STAGE(PG8_SB(0, 0), cB, voffB); PG8_STAGE(PG8_SB(0, 1), cB + hstep, voffB); PG8_STAGE(PG8_SA(0, 0), cA, voffA); PG8_STAGE(PG8_SA(0, 1), cA + hstep, voffA);
        if (wr == 1) PG8_BAR;
        PG8_WAIT_V(2); PG8_BAR;
        PG8_STAGE(PG8_SB(1, 0), cB + kstep, voffB); PG8_STAGE(PG8_SA(1, 0), cA + kstep, voffA); PG8_STAGE(PG8_SB(1, 1), cB + hstep + kstep, voffB);
        PG8_WAIT_V(6); PG8_BAR;
    } else {
        PG8_STAGE(PG8_SB(0, 0), cB, voffB); PG8_STAGE(PG8_SA(0, 0), cA, voffA); PG8_STAGE(PG8_SB(0, 1), cB + hstep, voffB); PG8_STAGE(PG8_SA(0, 1), cA + hstep, voffA);
        if (wr == 1) PG8_BAR;
        PG8_WAIT_V(4); PG8_BAR;
        PG8_STAGE(PG8_SB(1, 0), cB + kstep, voffB); PG8_STAGE(PG8_SA(1, 0), cA + kstep, voffA); PG8_STAGE(PG8_SB(1, 1), cB + hstep + kstep, voffB);
        PG8_WAIT_V(6); PG8_BAR;
    }
    for (;;) {
        const bool has_next = S.next(ui + 1, nxt);
        const char* nA = has_next ? (const char*)g.A + (size_t)nxt.pm * tstep : cA; const char* nB = has_next ? (const char*)g.Bt + (size_t)nxt.pn * tstep : cB;
        for (int t = 0; t < nt; t += 2) {
            const bool last = (t == nt - 2);
            const char* a1 = cA + (size_t)(t + 1) * kstep;
            const char* a2 = last ? nA : cA + (size_t)(t + 2) * kstep; const char* b2 = last ? nB : cB + (size_t)(t + 2) * kstep;
            const char* a3 = a2 + kstep; const char* b3 = b2 + kstep;
            if (last && has_next) S.a_ready(nxt);
            if constexpr (SP2) {
            PG8_LDB(B0, 0, 0); PG8_LDB(B1, 0, 1); PG8_SCHED; PG8_LDA(At, 0, 0); PG8_STAGE(PG8_SA(1, 1), a1 + hstep, voffA);
            PG8_WAIT_V(8); PG8_WAIT_L(0); PG8_BAR; PG8_MMA(0, 0, At, B0); PG8_MMA(0, 1, At, B1); PG8_BAR; PG8_SCHED;
            PG8_LDA(At, 0, 1); PG8_STAGE(PG8_SB(0, 0), b2, voffB); PG8_STAGE(PG8_SB(0, 1), b2 + hstep, voffB); PG8_STAGE(PG8_SA(0, 0), a2, voffA);
            PG8_WAIT_V(8); PG8_WAIT_L(0); PG8_BAR; PG8_MMA(1, 0, At, B0); PG8_MMA(1, 1, At, B1); PG8_BAR; PG8_SCHED;
            PG8_LDB(B0, 1, 0); PG8_LDB(B1, 1, 1); PG8_SCHED; PG8_LDA(At, 1, 0); PG8_STAGE(PG8_SA(0, 1), a2 + hstep, voffA);
            PG8_WAIT_V(8); PG8_WAIT_L(0); PG8_BAR; PG8_MMA(0, 0, At, B0); PG8_MMA(0, 1, At, B1); PG8_BAR; PG8_SCHED;
            PG8_LDA(At, 1, 1); PG8_STAGE(PG8_SB(1, 0), b3, voffB); PG8_STAGE(PG8_SB(1, 1), b3 + hstep, voffB); PG8_STAGE(PG8_SA(1, 0), a3, voffA);
            PG8_WAIT_V(8); PG8_WAIT_L(0); PG8_BAR; PG8_MMA(1, 0, At, B0); PG8_MMA(1, 1, At, B1); PG8_BAR; PG8_SCHED;
            } else {
            PG8_LDB(B0, 0, 0); PG8_SCHED; PG8_LDA(At, 0, 0); PG8_STAGE(PG8_SA(1, 1), a1 + hstep, voffA);
            PG8_WAIT_L(8); PG8_BAR; PG8_WAIT_L(0); PG8_MMA(0, 0, At, B0); PG8_BAR; PG8_SCHED;
            PG8_LDB(B1, 0, 1); PG8_STAGE(PG8_SB(0, 0), b2, voffB);
            PG8_BAR; PG8_WAIT_L(0); PG8_MMA(0, 1, At, B1); PG8_BAR;
            PG8_LDA(At, 0, 1); PG8_STAGE(PG8_SA(0, 0), a2, voffA);
            PG8_BAR; PG8_WAIT_L(0); PG8_MMA(1, 0, At, B0); PG8_BAR; PG8_SCHED;
            PG8_STAGE(PG8_SB(0, 1), b2 + hstep, voffB);
            PG8_WAIT_V(6); PG8_BAR; PG8_MMA(1, 1, At, B1); PG8_BAR;
            PG8_LDB(B0, 1, 0); PG8_SCHED; PG8_LDA(At, 1, 0); PG8_STAGE(PG8_SA(0, 1), a2 + hstep, voffA);
            PG8_WAIT_L(8); PG8_BAR; PG8_WAIT_L(0); PG8_MMA(0, 0, At, B0); PG8_BAR; PG8_SCHED;
            PG8_LDB(B1, 1, 1); PG8_STAGE(PG8_SB(1, 0), b3, voffB);
            PG8_BAR; PG8_WAIT_L(0); PG8_MMA(0, 1, At, B1); PG8_BAR;
            PG8_LDA(At, 1, 1); PG8_STAGE(PG8_SA(1, 0), a3, voffA);
            PG8_BAR; PG8_WAIT_L(0); PG8_MMA(1, 0, At, B0); PG8_BAR; PG8_SCHED;
            PG8_STAGE(PG8_SB(1, 1), b3 + hstep, voffB);
            PG8_WAIT_V(6); PG8_BAR; PG8_MMA(1, 1, At, B1); PG8_BAR;
            }
        }
        if constexpr (ALIGN_EPI) { if (wr == 0) PG8_BAR; }
        if constexpr (!Epi::AFTER_DRAIN) { E(acc, cur, wr, wc, fr, fq); S.done(cur); }
        if (!has_next) break;
#pragma unroll
        for (int a = 0; a < 2; ++a)
#pragma unroll
            for (int b = 0; b < 2; ++b)
#pragma unroll
                for (int m = 0; m < 4; ++m)
#pragma unroll
                    for (int n = 0; n < 2; ++n) acc[a][b][m][n] = (f32x4){0.f, 0.f, 0.f, 0.f};
        cur = nxt; cA = nA; cB = nB; ++ui;
        if constexpr (ALIGN_EPI) { if (wr == 1) PG8_BAR; }
    }
    PG8_WAIT_V(0);
    if constexpr (!ALIGN_EPI) { if (wr == 0) PG8_BAR; }
    PG8_BAR;
    if constexpr (Epi::AFTER_DRAIN) { E.fused(acc, cur, wr, wc, fr, fq, lds, wid, lane); S.done(cur); }
#undef PG8_SA
#undef PG8_SB
#undef PG8_STAGE
#undef PG8_LDA
#undef PG8_LDB
#undef PG8_MMA
#undef PG8_WAIT_V
#undef PG8_WAIT_L
#undef PG8_BAR
#undef PG8_SCHED
}
}
#define GAS __attribute__((address_space(1)))
#define LAS __attribute__((address_space(3)))
typedef unsigned short bf16;
typedef unsigned v4u __attribute__((ext_vector_type(4)));
typedef float f32x4 __attribute__((ext_vector_type(4)));
typedef short bf16x8 __attribute__((ext_vector_type(8)));
typedef GAS unsigned gu32;
typedef GAS unsigned long long gu64;
#define RLX_AGENT __ATOMIC_RELAXED, __HIP_MEMORY_SCOPE_AGENT
#define LDS_WAIT() asm volatile("s_waitcnt lgkmcnt(0)" ::: "memory")
#define VM_WAIT() asm volatile("s_waitcnt vmcnt(0)" ::: "memory")
__device__ __forceinline__ unsigned long long rt() { return __builtin_amdgcn_s_memrealtime(); }
__device__ __forceinline__ unsigned f2bf(float f) { unsigned u = __builtin_bit_cast(unsigned, f); return (u + 0x7fffu + ((u >> 16) & 1u)) >> 16; }
__device__ __forceinline__ unsigned pk2(float lo, float hi) { return f2bf(lo) | (f2bf(hi) << 16); }

#define XB_TMO      128
#define XB_XCNT(j)  (256  + 64 * (j))
#define XB_XSUB(j)  (1280 + 64 * (j))
#define XB_XGEN(j)  (2304 + 64 * (j))
#define XB_TOP      3328
#define XB_TOPGEN   3392
#define XCD_BAR_WORDS 3456
#define XB_SPIN_CAP (1u << 18)

__device__ __forceinline__ unsigned xb_ld(unsigned* p)              { return __hip_atomic_load(p, __ATOMIC_RELAXED, __HIP_MEMORY_SCOPE_AGENT); }
__device__ __forceinline__ unsigned xb_add(unsigned* p, unsigned v) { return __hip_atomic_fetch_add(p, v, __ATOMIC_RELAXED, __HIP_MEMORY_SCOPE_AGENT); }
__device__ __forceinline__ unsigned xb_xcc_id() { return (unsigned)__builtin_amdgcn_s_getreg((3 << 11) | 20) & 0xFu; }
#define XB_SPIN(cond, bar) do { unsigned _sp = 0; while (cond) { __builtin_amdgcn_s_sleep(1); \
    if ((++_sp & 255u) == 0u) { if (xb_ld(&(bar)[XB_TMO])) break; if (_sp > XB_SPIN_CAP) { atomicAdd(&(bar)[XB_TMO], 1u); break; } } } } while (0)

struct XcdBarrier {
    unsigned* bar; unsigned x;
    volatile LAS unsigned* st;
};

__device__ __forceinline__ XcdBarrier xcd_barrier_post(unsigned* bar, volatile LAS unsigned* st) {
    XcdBarrier b; b.bar = bar; b.x = xb_xcc_id(); b.st = st;
    if (threadIdx.x == 0) (void)xb_add(&bar[XB_XCNT(b.x)], 1u);
    return b;
}
__device__ __forceinline__ void xcd_barrier_complete(unsigned* bar, unsigned x, unsigned& nloc, unsigned& nx) {
    const unsigned G = gridDim.x * gridDim.y * gridDim.z;
    unsigned sum, cnt, mine, sp = 0u;
    for (;;) {
        sum = 0u; cnt = 0u; mine = 0u;
#pragma unroll
        for (unsigned j = 0; j < 16; ++j) { const unsigned c = xb_ld(&bar[XB_XCNT(j)]); sum += c; cnt += (c > 0u) ? 1u : 0u; mine = (j == x) ? c : mine; }
        if (sum == G) break;
        __builtin_amdgcn_s_sleep(1);
        if ((++sp & 255u) == 0u) { if (xb_ld(&bar[XB_TMO])) break; if (sp > XB_SPIN_CAP) { atomicAdd(&bar[XB_TMO], 1u); break; } }
    }
    nloc = mine > 0u ? mine : 1u; nx = cnt > 0u ? cnt : 1u;
}

__device__ __forceinline__ void xcd_barrier(const XcdBarrier& b) {
    asm volatile("s_waitcnt vmcnt(0)" ::: "memory");
    __syncthreads();
    if (threadIdx.x == 0) {
        unsigned* bar = b.bar;
        __builtin_amdgcn_s_waitcnt(0);
        unsigned nloc = b.st[0], nx = b.st[1];
        if (nloc == 0u) { xcd_barrier_complete(bar, b.x, nloc, nx); b.st[0] = nloc; b.st[1] = nx; }
        const unsigned old = xb_add(&bar[XB_XSUB(b.x)], 1u);
        const unsigned gen = old / nloc;
        if (old + 1u == (gen + 1u) * nloc) {
            __builtin_amdgcn_fence(__ATOMIC_RELEASE, "agent");
            asm volatile("s_waitcnt vmcnt(0)" ::: "memory");
            const unsigned og = xb_add(&bar[XB_TOP], 1u);
            const unsigned tg = og / nx;
            if (og + 1u == (tg + 1u) * nx) xb_add(&bar[XB_TOPGEN], 1u);
            else XB_SPIN(xb_ld(&bar[XB_TOPGEN]) == tg, bar);
            __builtin_amdgcn_fence(__ATOMIC_ACQUIRE, "agent");
            xb_add(&bar[XB_XGEN(b.x)], 1u);
            asm volatile("s_waitcnt vmcnt(0)" ::: "memory");
        } else {
            XB_SPIN(xb_ld(&bar[XB_XGEN(b.x)]) == gen, bar);
            __builtin_amdgcn_fence(__ATOMIC_ACQUIRE, "agent");
            asm volatile("s_waitcnt vmcnt(0)" ::: "memory");
        }
    }
    __syncthreads();
}
constexpr int NWAVES = 8;
constexpr int DM = 1024, SEQ = 4096, NB = 4, MP = NB * SEQ, SB = 128, ST = 4, MS = SB * ST, MT = MP + MS;
constexpr int DH = 512, NH = 8, HD = 64, DIN = 3072, WBUF = 2048;
constexpr int NCH = SEQ / 64;
constexpr float LN_EPS = 1e-5f;
constexpr float ALPHA = 1.1892071150027210667f;
constexpr float LOG2E = 1.4426950408889634f;
constexpr float QSCALE = 0.125f * LOG2E;
constexpr float NEGBIG = -1.0e30f;
constexpr size_t OUT_YP = 0, OUT_YS = 16777216, OUT_KP = 17301504, OUT_VP = 21495808, OUT_CP = 25690112, OUT_HP = 25696256,
                 OUT_KS = 25698304, OUT_VS = 25960448, OUT_CS = 26222592, OUT_HS = 26419200, OUT_END = 26484736;
constexpr size_t MiB = 1u << 20;
constexpr size_t WS_CTL = 0, CTL_ZERO_BYTES = 1 * MiB;
constexpr size_t WS_WIN = 2 * MiB, WS_WOUT = 8 * MiB;
constexpr size_t WS_WG = 10 * MiB, WS_SP8 = 11 * MiB;
constexpr size_t WS_XB = 16 * MiB;
constexpr size_t WS_Q = 64 * MiB, WS_K = 81 * MiB, WS_V = 98 * MiB, WS_GA = 115 * MiB, WS_XL = 132 * MiB, WS_GL = 149 * MiB;
constexpr size_t WS_O0 = 176 * MiB, WS_O1 = 192 * MiB, WS_O2 = 208 * MiB;
constexpr size_t WS_ML = 224 * MiB;
constexpr size_t WS_HL = 232 * MiB, WS_PP = 248 * MiB;
constexpr size_t WS_SUM = 264 * MiB;
constexpr size_t WS_Q2F = 266 * MiB;
constexpr size_t WS_MIX = 272 * MiB;
constexpr size_t WS_Z = 320 * MiB;
constexpr size_t WS_END = 392 * MiB;
constexpr int CW_BAR = 4096;
constexpr int PHASE_BYTES = 133120;
constexpr int MISC_OFF = PHASE_BYTES, WSCR_OFF = MISC_OFF + 256, LDS_BYTES = 147456;
static_assert(WSCR_OFF + NWAVES * 256 <= LDS_BYTES, "LDS map");

typedef unsigned u32x2 __attribute__((ext_vector_type(2)));
typedef float f32x2 __attribute__((ext_vector_type(2)));
typedef float f32x16 __attribute__((ext_vector_type(16)));
typedef short s16x4 __attribute__((ext_vector_type(4)));

__device__ __forceinline__ float bflo(unsigned w) { return __uint_as_float(w << 16); }
__device__ __forceinline__ float bfhi(unsigned w) { return __uint_as_float(w & 0xffff0000u); }
__device__ __forceinline__ float fast_exp2(float x) { return __builtin_amdgcn_exp2f(x); }
__device__ __forceinline__ float sigmoidf_(float x) { return __builtin_amdgcn_rcpf(1.0f + fast_exp2(-x * LOG2E)); }
__device__ __forceinline__ float siluf_(float x) { return x * sigmoidf_(x); }
__device__ __forceinline__ float wave_sum(float v) {
#pragma unroll
    for (int o = 1; o < 64; o <<= 1) v += __shfl_xor(v, o);
    return v;
}

struct EpiProj {
    static constexpr bool PERM = true, AFTER_DRAIN = false;
    bf16 *Qb, *Kb, *Vb, *GAb, *XLb, *GLb; float* Q2f; float* out;
    __device__ __forceinline__ void operator()(const f32x4 (&acc)[2][2][4][2], const pg8::Unit& u, int wr, int wc, int fr, int fq) const {
        const int kind = u.pn >> 1;
        const int cs0 = (u.pn & 1) * 256 + wc * 32 + 8 * fq;
        const int rowt = u.pm * 256 + wr * 64 + fr;
        const bool samp = u.pm >= (MP / 256);
        bf16* dstb = kind == 0 ? Qb : kind == 1 ? Kb : kind == 2 ? Vb : kind == 3 ? GAb : kind == 4 ? XLb : GLb;
#pragma unroll
        for (int ai = 0; ai < 2; ++ai)
#pragma unroll
            for (int m = 0; m < 4; ++m) {
                const int row = rowt + ai * 128 + m * 16;
                float* fo = nullptr;
                if (kind == 1 || kind == 2) {
                    if (!samp) { const int t = row & (SEQ - 1), b = row >> 12; if (t >= SEQ - WBUF) fo = out + (kind == 1 ? OUT_KP : OUT_VP) + (size_t)(b * WBUF + t - (SEQ - WBUF)) * DH; }
                    else fo = out + (kind == 1 ? OUT_KS : OUT_VS) + (size_t)(row - MP) * DH;
                } else if (kind == 4) {
                    if (!samp) { const int t = row & (SEQ - 1), b = row >> 12; if (t >= SEQ - 3) fo = out + OUT_CP + (size_t)(b * 3 + t - (SEQ - 3)) * DH; }
                    else { const int rs = row - MP, ts = rs & 3; if (ts >= 1) fo = out + OUT_CS + (size_t)((rs >> 2) * 3 + ts - 1) * DH; }
                } else if (kind == 0 && samp) fo = Q2f + (size_t)(row - MP) * DH;
#pragma unroll
                for (int bj = 0; bj < 2; ++bj) {
                    f32x4 v0 = acc[ai][bj][m][0], v1 = acc[ai][bj][m][1];
                    const int cs = cs0 + bj * 128;
                    if (kind == 0) { v0 = v0 * QSCALE; v1 = v1 * QSCALE; }
                    if (kind == 3 || kind == 5) {
#pragma unroll
                        for (int e = 0; e < 4; ++e) { v0[e] = siluf_(v0[e]); v1[e] = siluf_(v1[e]); }
                    }
                    if (fo) { *(f32x4*)(fo + cs) = v0; *(f32x4*)(fo + cs + 4) = v1; }
                    pg8::u32x4 w; w.x = pg8::cvt_pk_bf16(v0[0], v0[1]); w.y = pg8::cvt_pk_bf16(v0[2], v0[3]); w.z = pg8::cvt_pk_bf16(v1[0], v1[1]); w.w = pg8::cvt_pk_bf16(v1[2], v1[3]);
                    *(pg8::u32x4*)(dstb + (size_t)row * DH + cs) = w;
                }
            }
    }
};
struct EpiZ {
    static constexpr bool PERM = false, AFTER_DRAIN = false;
    const float* xp; const float* xs; float* Z;
    __device__ __forceinline__ void operator()(const f32x4 (&acc)[2][2][4][2], const pg8::Unit& u, int wr, int wc, int fr, int fq) const {
        const int col0 = u.pn * 256 + wc * 32 + 4 * fq;
#pragma unroll
        for (int ai = 0; ai < 2; ++ai)
#pragma unroll
            for (int m = 0; m < 4; ++m) {
                const int row = u.pm * 256 + ai * 128 + wr * 64 + m * 16 + fr;
                const float* xr = row < MP ? xp + (size_t)row * DM : xs + (size_t)(row - MP) * DM;
                float* zr = Z + (size_t)row * DM;
#pragma unroll
                for (int bj = 0; bj < 2; ++bj)
#pragma unroll
                    for (int n = 0; n < 2; ++n) { const int c = col0 + bj * 128 + n * 16; const f32x4 xv = *(const f32x4*)(xr + c); *(f32x4*)(zr + c) = xv * ALPHA + acc[ai][bj][m][n]; }
            }
    }
};

struct Frame {
    LAS unsigned char* lds;
    volatile LAS unsigned* MISC;
    gu32* ctl;
    int tid, lane, wave, G;
    const float *xp, *xs, *ck, *cv, *sconv, *sh, *w_in, *conv_w, *conv_b, *w_ra, *b_ra, *w_ri, *b_ri, *lam, *w_out, *ln_g, *ln_b;
    float* out;
    bf16 *WG; float* SP8;
    bf16 *WinT, *WoutT, *XB, *Qb, *Kb, *Vb, *GAb, *XLb, *GLb, *O0, *O1, *O2, *HL, *PP, *MIX;
    float *ML, *SUM, *Q2f, *Z;
};

__device__ __forceinline__ void p0_transpose_item(const float* W, int K, int N, bf16* WT, LAS float* scr, int item, int lane) {
    const int nblk = N / 32, kb = item / nblk, nb = item % nblk, k0 = 64 * kb, n0 = 32 * nb;
#pragma unroll 8
    for (int i = 0; i < 32; ++i) { const int kk = 2 * i + (lane >> 5); scr[kk * 33 + (lane & 31)] = W[(size_t)(k0 + kk) * N + n0 + (lane & 31)]; }
    LDS_WAIT(); asm volatile("" ::: "memory");
    const int c = lane & 7;
#pragma unroll
    for (int j = 0; j < 4; ++j) { const int n = (lane >> 3) + 8 * j; const LAS float* s = scr + (8 * c) * 33 + n;
        v4u o; o.x = pk2(s[0 * 33], s[1 * 33]); o.y = pk2(s[2 * 33], s[3 * 33]); o.z = pk2(s[4 * 33], s[5 * 33]); o.w = pk2(s[6 * 33], s[7 * 33]);
        *(GAS v4u*)(WT + (size_t)(n0 + n) * K + k0 + 8 * c) = o; }
    LDS_WAIT(); asm volatile("" ::: "memory");
}
__device__ __forceinline__ void p0_prologue(Frame& F) {
    LAS float* scr = (LAS float*)(F.lds + F.wave * 16384);
    const int gw = blockIdx.x * NWAVES + F.wave, NGW = F.G * NWAVES;
    constexpr int I_IN = (DM / 64) * (DIN / 32), I_OUT = (DM / 64) * (DM / 32);
    for (int it = gw; it < I_IN + I_OUT; it += NGW) {
        if (it < I_IN) p0_transpose_item(F.w_in, DM, DIN, F.WinT, scr, it, F.lane);
        else p0_transpose_item(F.w_out, DM, DM, F.WoutT, scr, it - I_IN, F.lane);
    }
    for (int i = blockIdx.x * (NWAVES * 64) + F.tid; i < 2 * 8 * 2 * 4 * 64; i += F.G * NWAVES * 64) {
        const int ln = i & 63, s = (i >> 6) & 3, mt = (i >> 8) & 1, g = (i >> 9) & 7, gate = i >> 12;
        const int m = ln & 31, hi = ln >> 5, rr = (m & 3) + 4 * (m >> 3), hp = (m >> 2) & 1, idx = 16 * mt + rr, oc = 16 * (idx >> 3) + 8 * hp + (idx & 7);
        const float* W = gate ? F.w_ri : F.w_ra;
        float a[8];
#pragma unroll
        for (int j = 0; j < 8; ++j) a[j] = W[(size_t)(g * 64 + 16 * s + 8 * hi + j) * 64 + oc];
        v4u o; o.x = pk2(a[0], a[1]); o.y = pk2(a[2], a[3]); o.z = pk2(a[4], a[5]); o.w = pk2(a[6], a[7]);
        *(v4u*)(F.WG + (size_t)i * 8) = o;
    }
    for (int i = blockIdx.x * (NWAVES * 64) + F.tid; i < DH; i += F.G * NWAVES * 64) F.SP8[i] = 8.0f * log1pf(expf(-F.lam[i]));
    constexpr size_t NCHK = (size_t)MT * DM / 8, PCHK = (size_t)MP * DM / 8;
    for (size_t i = (size_t)gw * 64 + F.lane; i < NCHK; i += (size_t)NGW * 64) {
        const float* src = i < PCHK ? F.xp + i * 8 : F.xs + (i - PCHK) * 8;
        const f32x4 a = *(const f32x4*)src, b = *(const f32x4*)(src + 4);
        v4u o; o.x = pg8::cvt_pk_bf16(a[0], a[1]); o.y = pg8::cvt_pk_bf16(a[2], a[3]); o.z = pg8::cvt_pk_bf16(b[0], b[1]); o.w = pg8::cvt_pk_bf16(b[2], b[3]);
        *(v4u*)(F.XB + i * 8) = o;
    }
}

constexpr int A_K = 0, A_V = 49152, A_STG = 98304;
__device__ __forceinline__ int crow(int r, int hi) { return (r & 3) + 8 * (r >> 2) + 4 * hi; }
__device__ __forceinline__ void attn_unit(Frame& F, const bf16* __restrict__ Q, const bf16* __restrict__ K, const bf16* __restrict__ V, bf16* __restrict__ O, float* __restrict__ ML,
                                          int d, int b, int h, int rc, int qb) {
    LAS unsigned char* L = F.lds;
    const int tid = F.tid, lane = F.lane, w = F.wave, q = lane & 31, hi = lane >> 5;
    const int i0 = qb * 256;
    const size_t rowb = (size_t)b * SEQ;
    {
        const int c = tid & 7, r0 = tid >> 3;
        v4u kr[6], vr[6];
#pragma unroll
        for (int ps = 0; ps < 6; ++ps) {
            const int row = ps * 64 + r0, i = i0 - 128 + row;
            if (i >= 0) { const size_t g = (rowb + (size_t)i * d + rc) * DH + h * HD + c * 8; kr[ps] = *(const v4u*)(K + g); vr[ps] = *(const v4u*)(V + g); }
            else { kr[ps] = (v4u){0u, 0u, 0u, 0u}; vr[ps] = (v4u){0u, 0u, 0u, 0u}; }
        }
#pragma unroll
        for (int ps = 0; ps < 6; ++ps) {
            const int row = ps * 64 + r0;
            *(LAS v4u*)(L + A_K + row * 128 + ((c ^ ((row >> 1) & 7)) << 4)) = kr[ps];
            *(LAS v4u*)(L + A_V + row * 128 + ((c ^ (((row >> 1) & 1) << 2)) << 4)) = vr[ps];
        }
    }
    const size_t qrow = rowb + (size_t)(i0 + 32 * w + q) * d + rc;
    bf16x8 qr[4];
#pragma unroll
    for (int s = 0; s < 4; ++s) qr[s] = *(const bf16x8*)(Q + qrow * DH + h * HD + 16 * s + 8 * hi);
    __syncthreads();
    f32x16 S[5];
#pragma unroll
    for (int kt = 0; kt < 5; ++kt) {
        const int krow = 32 * w + 32 * kt + q;
        f32x16 a = {};
#pragma unroll
        for (int s = 0; s < 4; ++s) {
            const bf16x8 kf = *(const LAS bf16x8*)(L + A_K + krow * 128 + (((2 * s + hi) ^ ((krow >> 1) & 7)) << 4));
            a = __builtin_amdgcn_mfma_f32_32x32x16_bf16(kf, qr[s], a, 0, 0, 0);
        }
        S[kt] = a;
    }
    const int kpos0 = i0 + 32 * w - 128;
    float mx = NEGBIG;
#pragma unroll
    for (int kt = 0; kt < 5; ++kt)
#pragma unroll
        for (int r = 0; r < 16; ++r) {
            const int kk = 32 * kt + crow(r, hi);
            const bool valid = (kk >= q) && (kk <= q + 128) && (kpos0 + kk >= 0);
            const float sv = valid ? S[kt][r] : NEGBIG;
            S[kt][r] = sv; mx = fmaxf(mx, sv);
        }
    mx = fmaxf(mx, __shfl_xor(mx, 32));
    float ls = 0.f;
#pragma unroll
    for (int kt = 0; kt < 5; ++kt)
#pragma unroll
        for (int r = 0; r < 16; ++r) { const float p = fast_exp2(S[kt][r] - mx); S[kt][r] = p; ls += p; }
    ls += __shfl_xor(ls, 32);
    f32x16 o[2]; o[0] = (f32x16){}; o[1] = (f32x16){};
    const int trq = (lane & 15) >> 2, trp = lane & 3, blk = (lane >> 4) & 1;
#pragma unroll
    for (int kt = 0; kt < 5; ++kt)
#pragma unroll
        for (int s2 = 0; s2 < 2; ++s2) {
            v4u pw; pw.x = pg8::cvt_pk_bf16(S[kt][8 * s2 + 0], S[kt][8 * s2 + 1]); pw.y = pg8::cvt_pk_bf16(S[kt][8 * s2 + 2], S[kt][8 * s2 + 3]);
            pw.z = pg8::cvt_pk_bf16(S[kt][8 * s2 + 4], S[kt][8 * s2 + 5]); pw.w = pg8::cvt_pk_bf16(S[kt][8 * s2 + 6], S[kt][8 * s2 + 7]);
            const bf16x8 pa = __builtin_bit_cast(bf16x8, pw);
#pragma unroll
            for (int c = 0; c < 2; ++c) {
                s16x4 vt[2];
#pragma unroll
                for (int t = 0; t < 2; ++t) {
                    const int row = 32 * w + 32 * kt + 16 * s2 + 8 * t + 4 * hi + trq;
                    const int chunk = 4 * c + 2 * blk + (trp >> 1);
                    vt[t] = __builtin_bit_cast(s16x4, __builtin_amdgcn_ds_read_tr16_b64_v4i16((LAS s16x4*)(L + A_V + row * 128 + ((chunk ^ (((row >> 1) & 1) << 2)) << 4) + 8 * (trp & 1))));
                }
                const bf16x8 vf = (bf16x8){vt[0][0], vt[0][1], vt[0][2], vt[0][3], vt[1][0], vt[1][1], vt[1][2], vt[1][3]};
                o[c] = __builtin_amdgcn_mfma_f32_32x32x16_bf16(pa, vf, o[c], 0, 0, 0);
            }
        }
    LAS float* wscr = (LAS float*)(L + WSCR_OFF + w * 256);
    if (hi == 0) { wscr[q] = ls; *(f32x2*)(ML + (qrow * NH + h) * 2) = (f32x2){mx, ls}; }
    LDS_WAIT(); asm volatile("" ::: "memory");
    LAS unsigned short* stg = (LAS unsigned short*)(L + A_STG + w * 4096);
#pragma unroll
    for (int r = 0; r < 16; ++r) {
        const int qo = crow(r, hi);
        const float li = __builtin_amdgcn_rcpf(wscr[qo]);
        stg[qo * 64 + q] = (unsigned short)f2bf(o[0][r] * li);
        stg[qo * 64 + 32 + q] = (unsigned short)f2bf(o[1][r] * li);
    }
    LDS_WAIT(); asm volatile("" ::: "memory");
#pragma unroll
    for (int i = 0; i < 4; ++i) {
        const int row = i * 8 + (lane >> 3), ch = lane & 7;
        const v4u v = *(const LAS v4u*)((LAS unsigned char*)stg + row * 128 + ch * 16);
        *(v4u*)(O + (rowb + (size_t)(i0 + 32 * w + row) * d + rc) * DH + h * HD + ch * 8) = v;
    }
    __syncthreads();
}

constexpr int SCAN_WAVE_BYTES = 2 * 32 * 65 * 4;
static_assert(NWAVES * SCAN_WAVE_BYTES <= PHASE_BYTES, "scan tiles");
__device__ __forceinline__ float neg_expm1(float x, float ex) {
    const float p = -x * (1.0f + x * (0.5f + x * (0.16666667f + x * (0.041666668f + x * (0.0083333338f + x * 0.0013888889f)))));
    return x > -0.25f ? p : 1.0f - ex;
}
__device__ __forceinline__ void lru_unit(Frame& F, int b, int c) {
    const int lane = F.lane, g = F.wave, tl = lane & 31, hi = lane >> 5;
    LAS float* As = (LAS float*)(F.lds + g * SCAN_WAVE_BYTES);
    LAS float* Bs = As + 32 * 65;
    float hc = 0.f, pc = 1.f;
    const size_t rowb = (size_t)b * SEQ;
    for (int nt = 0; nt < 2; ++nt) {
        const int t = 64 * c + 32 * nt + tl;
        float u[32];
        bf16x8 ub[4];
#pragma unroll
        for (int s = 0; s < 4; ++s) {
            const int ch0 = 64 * g + 16 * s + 8 * hi;
            float acc8[8];
            { const f32x4 c0 = *(const f32x4*)(F.conv_b + ch0), c1 = *(const f32x4*)(F.conv_b + ch0 + 4);
              acc8[0] = c0[0]; acc8[1] = c0[1]; acc8[2] = c0[2]; acc8[3] = c0[3]; acc8[4] = c1[0]; acc8[5] = c1[1]; acc8[6] = c1[2]; acc8[7] = c1[3]; }
#pragma unroll
            for (int wv = 0; wv < 4; ++wv) {
                const int tt = t - 3 + wv;
                v4u xw = (v4u){0u, 0u, 0u, 0u};
                if (tt >= 0) xw = *(const v4u*)(F.XLb + (rowb + tt) * DH + ch0);
                const f32x4 w0 = *(const f32x4*)(F.conv_w + wv * DH + ch0), w1 = *(const f32x4*)(F.conv_w + wv * DH + ch0 + 4);
                acc8[0] += w0[0] * bflo(xw.x); acc8[1] += w0[1] * bfhi(xw.x); acc8[2] += w0[2] * bflo(xw.y); acc8[3] += w0[3] * bfhi(xw.y);
                acc8[4] += w1[0] * bflo(xw.z); acc8[5] += w1[1] * bfhi(xw.z); acc8[6] += w1[2] * bflo(xw.w); acc8[7] += w1[3] * bfhi(xw.w);
            }
#pragma unroll
            for (int j = 0; j < 8; ++j) u[8 * s + j] = acc8[j];
            v4u pk; pk.x = pg8::cvt_pk_bf16(acc8[0], acc8[1]); pk.y = pg8::cvt_pk_bf16(acc8[2], acc8[3]); pk.z = pg8::cvt_pk_bf16(acc8[4], acc8[5]); pk.w = pg8::cvt_pk_bf16(acc8[6], acc8[7]);
            ub[s] = __builtin_bit_cast(bf16x8, pk);
        }
        f32x16 aR[2], aI[2];
#pragma unroll
        for (int mt = 0; mt < 2; ++mt) {
            f32x16 x = {}, y = {};
#pragma unroll
            for (int s = 0; s < 4; ++s) {
                const bf16x8 wr_ = *(const bf16x8*)(F.WG + ((size_t)(((0 * 8 + g) * 2 + mt) * 4 + s) * 64 + lane) * 8);
                const bf16x8 wi_ = *(const bf16x8*)(F.WG + ((size_t)(((1 * 8 + g) * 2 + mt) * 4 + s) * 64 + lane) * 8);
                x = __builtin_amdgcn_mfma_f32_32x32x16_bf16(wr_, ub[s], x, 0, 0, 0); y = __builtin_amdgcn_mfma_f32_32x32x16_bf16(wi_, ub[s], y, 0, 0, 0);
            }
            aR[mt] = x; aI[mt] = y;
        }
#pragma unroll
        for (int s = 0; s < 4; ++s) {
            const int ch0 = 64 * g + 16 * s + 8 * hi;
            float bra[8], bri[8], sp[8];
            { const f32x4 a0 = *(const f32x4*)(F.b_ra + ch0), a1 = *(const f32x4*)(F.b_ra + ch0 + 4), b0 = *(const f32x4*)(F.b_ri + ch0), b1 = *(const f32x4*)(F.b_ri + ch0 + 4),
                          l0 = *(const f32x4*)(F.SP8 + ch0), l1 = *(const f32x4*)(F.SP8 + ch0 + 4);
#pragma unroll
              for (int e = 0; e < 4; ++e) { bra[e] = a0[e]; bra[4 + e] = a1[e]; bri[e] = b0[e]; bri[4 + e] = b1[e]; sp[e] = l0[e]; sp[4 + e] = l1[e]; } }
#pragma unroll
            for (int j = 0; j < 8; ++j) {
                const int idx = 8 * s + j, mt = idx >> 4, r = idx & 15;
                const float xr = aR[mt][r] + bra[j], xi = aI[mt][r] + bri[j];
                const float rg = sigmoidf_(xr), ig = sigmoidf_(xi);
                const float la = -rg * sp[j];
                const float a = fast_exp2(la * LOG2E);
                const float mult = sqrtf(neg_expm1(2.0f * la, a * a));
                const float bx = mult * ig * u[idx];
                const int cl = 16 * s + 8 * hi + j;
                As[tl * 65 + cl] = a; Bs[tl * 65 + cl] = bx;
            }
        }
        LDS_WAIT(); asm volatile("" ::: "memory");
        {
            bf16* hl = F.HL + (rowb + 64 * c + 32 * nt) * DH + 64 * g + lane;
            bf16* pp = F.PP + (rowb + 64 * c + 32 * nt) * DH + 64 * g + lane;
#pragma unroll 8
            for (int tt = 0; tt < 32; ++tt) {
                const float a = As[tt * 65 + lane], bx = Bs[tt * 65 + lane];
                hc = a * hc + bx; pc = pc * a;
                hl[(size_t)tt * DH] = (bf16)f2bf(hc); pp[(size_t)tt * DH] = (bf16)f2bf(pc);
            }
        }
        LDS_WAIT(); asm volatile("" ::: "memory");
    }
    *(f32x2*)(F.SUM + ((size_t)(b * NCH + c) * DH + 64 * g + lane) * 2) = (f32x2){pc, hc};
}

__device__ __forceinline__ float red16(float v) { v += __shfl_xor(v, 1); v += __shfl_xor(v, 2); v += __shfl_xor(v, 4); v += __shfl_xor(v, 8); return v; }
struct SmpSt { f32x4 qA, qB, aA, aB; float mA, mB, lA, lB; };
__device__ __forceinline__ void smp_key(SmpSt& S, const f32x4 kA, const f32x4 kB, const f32x4 vA, const f32x4 vB) {
    float sA = S.qA[0] * kA[0] + S.qA[1] * kA[1] + S.qA[2] * kA[2] + S.qA[3] * kA[3];
    float sB = S.qB[0] * kB[0] + S.qB[1] * kB[1] + S.qB[2] * kB[2] + S.qB[3] * kB[3];
    sA = red16(sA); sB = red16(sB);
    { const float mn = fmaxf(S.mA, sA), sc = fast_exp2(S.mA - mn), p = fast_exp2(sA - mn); S.lA = S.lA * sc + p; S.aA = S.aA * sc + vA * p; S.mA = mn; }
    { const float mn = fmaxf(S.mB, sB), sc = fast_exp2(S.mB - mn), p = fast_exp2(sB - mn); S.lB = S.lB * sc + p; S.aB = S.aB * sc + vB * p; S.mB = mn; }
}
constexpr int SMP_ACC = 0, SMP_ML = 16384, SMP_U = 16384 + 512;
__device__ __forceinline__ void sample_unit(Frame& F, int bs) {
    const int tid = F.tid, lane = F.lane, w = F.wave;
    LAS unsigned char* L = F.lds;
    const float* ck = F.ck + (size_t)bs * WBUF * DH;
    const float* cv = F.cv + (size_t)bs * WBUF * DH;
    const float* kn = F.out + OUT_KS + (size_t)bs * ST * DH;
    const float* vn = F.out + OUT_VS + (size_t)bs * ST * DH;
    const float* q2 = F.Q2f + (size_t)bs * ST * DH;
    const int lo = 4 * lane;
    const int ts = w & 3, half = w >> 2, dd = half ? 16 : 4;
    SmpSt S;
    S.qA = *(const f32x4*)(q2 + ts * DH + lo); S.qB = *(const f32x4*)(q2 + ts * DH + 256 + lo);
    S.aA = (f32x4){0.f, 0.f, 0.f, 0.f}; S.aB = S.aA; S.mA = NEGBIG; S.mB = NEGBIG; S.lA = 0.f; S.lB = 0.f;
    { const float* kp = kn + ts * DH; const float* vp = vn + ts * DH;
      smp_key(S, *(const f32x4*)(kp + lo), *(const f32x4*)(kp + 256 + lo), *(const f32x4*)(vp + lo), *(const f32x4*)(vp + 256 + lo)); }
    for (int j = 1; j <= 128; j += 4) {
        f32x4 kA[4], kB[4], vA[4], vB[4];
#pragma unroll
        for (int e = 0; e < 4; ++e) { const size_t ro = (size_t)(WBUF + ts - dd * (j + e)) * DH; kA[e] = *(const f32x4*)(ck + ro + lo); kB[e] = *(const f32x4*)(ck + ro + 256 + lo); vA[e] = *(const f32x4*)(cv + ro + lo); vB[e] = *(const f32x4*)(cv + ro + 256 + lo); }
#pragma unroll
        for (int e = 0; e < 4; ++e) smp_key(S, kA[e], kB[e], vA[e], vB[e]);
    }
    if (half == 0) {
        for (int tp = 0; tp <= ts; ++tp) { const float* kp = kn + tp * DH; const float* vp = vn + tp * DH;
            smp_key(S, *(const f32x4*)(kp + lo), *(const f32x4*)(kp + 256 + lo), *(const f32x4*)(vp + lo), *(const f32x4*)(vp + 256 + lo)); }
    }
    {
        const int rbase = half ? (WBUF - 128) : (WBUF - 64);
        for (int i = 0; i < 64; i += 4) {
            f32x4 kA[4], kB[4], vA[4], vB[4];
#pragma unroll
            for (int e = 0; e < 4; ++e) { const size_t ro = (size_t)(rbase + i + e) * DH; kA[e] = *(const f32x4*)(ck + ro + lo); kB[e] = *(const f32x4*)(ck + ro + 256 + lo); vA[e] = *(const f32x4*)(cv + ro + lo); vB[e] = *(const f32x4*)(cv + ro + 256 + lo); }
#pragma unroll
            for (int e = 0; e < 4; ++e) if (half == 0 || i + e >= ts) smp_key(S, kA[e], kB[e], vA[e], vB[e]);
        }
    }
    {
        LAS float* pa = (LAS float*)(L + SMP_ACC) + w * 512;
        LAS float* pm = (LAS float*)(L + SMP_ML) + w * 16;
        *(LAS f32x4*)(pa + lo) = S.aA; *(LAS f32x4*)(pa + 256 + lo) = S.aB;
        if ((lane & 15) == 0) { const int hA = lane >> 4; pm[hA * 2] = S.mA; pm[hA * 2 + 1] = S.lA; pm[(4 + hA) * 2] = S.mB; pm[(4 + hA) * 2 + 1] = S.lB; }
    }
    const int ch = tid, g = ch >> 6, oc = ch & 63;
    float uu[4];
    {
        float xc[7];
#pragma unroll
        for (int i = 0; i < 3; ++i) xc[i] = F.sconv[(size_t)(bs * 3 + i) * DH + ch];
#pragma unroll
        for (int t = 0; t < 4; ++t) xc[3 + t] = __uint_as_float((unsigned)F.XLb[(size_t)(MP + bs * ST + t) * DH + ch] << 16);
        const float cb = F.conv_b[ch];
        float cw[4];
#pragma unroll
        for (int wv = 0; wv < 4; ++wv) cw[wv] = F.conv_w[wv * DH + ch];
#pragma unroll
        for (int t = 0; t < 4; ++t) { uu[t] = cb + cw[0] * xc[t] + cw[1] * xc[t + 1] + cw[2] * xc[t + 2] + cw[3] * xc[t + 3]; ((LAS float*)(L + SMP_U))[t * 512 + ch] = uu[t]; }
    }
    __syncthreads();
    {
        const int hd = tid >> 6;
        const LAS float* pm = (const LAS float*)(L + SMP_ML);
        const LAS float* pa = (const LAS float*)(L + SMP_ACC);
#pragma unroll
        for (int t = 0; t < 4; ++t) {
            const float m0 = pm[t * 16 + hd * 2], l0 = pm[t * 16 + hd * 2 + 1], m1 = pm[(t + 4) * 16 + hd * 2], l1 = pm[(t + 4) * 16 + hd * 2 + 1];
            const float M = fmaxf(m0, m1), s0 = fast_exp2(m0 - M), s1 = fast_exp2(m1 - M);
            const float Ls = l0 * s0 + l1 * s1, Os = pa[t * 512 + tid] * s0 + pa[(t + 4) * 512 + tid] * s1;
            const size_t row = (size_t)MP + bs * ST + t;
            const float gate = __uint_as_float((unsigned)F.GAb[row * DH + tid] << 16);
            F.MIX[row * DM + tid] = (bf16)f2bf(Os / Ls * gate);
        }
    }
    {
        float xr[4], xi[4];
        const float bra = F.b_ra[ch], bri = F.b_ri[ch];
#pragma unroll
        for (int t = 0; t < 4; ++t) { xr[t] = bra; xi[t] = bri; }
        const float* wra = F.w_ra + (size_t)g * 4096 + oc; const float* wri = F.w_ri + (size_t)g * 4096 + oc;
        const LAS float* us = (const LAS float*)(L + SMP_U) + 64 * g;
#pragma unroll 8
        for (int i = 0; i < 64; ++i) { const float a = wra[i * 64], bq = wri[i * 64];
#pragma unroll
            for (int t = 0; t < 4; ++t) { const float x = us[t * 512 + i]; xr[t] += x * a; xi[t] += x * bq; } }
        float hcur = F.sh[(size_t)bs * DH + ch];
        const float sp = F.SP8[ch];
#pragma unroll
        for (int t = 0; t < 4; ++t) {
            const float rg = sigmoidf_(xr[t]), ig = sigmoidf_(xi[t]);
            const float la = -rg * sp, a = fast_exp2(la * LOG2E), mult = sqrtf(neg_expm1(2.0f * la, a * a));
            hcur = a * hcur + mult * ig * uu[t];
            const size_t row = (size_t)MP + bs * ST + t;
            const float gate = __uint_as_float((unsigned)F.GLb[row * DH + ch] << 16);
            F.MIX[row * DM + DH + ch] = (bf16)f2bf(hcur * gate);
        }
        F.out[OUT_HS + (size_t)bs * DH + ch] = hcur;
    }
    __syncthreads();
}

__device__ __forceinline__ void mix_unit(Frame& F, int b, int c) {
    const int tid = F.tid;
    LAS float* cs = (LAS float*)F.lds;
    {
        float carry = 0.f;
        const f32x2* sp = (const f32x2*)F.SUM + (size_t)b * NCH * DH + tid;
        for (int cc = 0; cc < c; ++cc) { const f32x2 ab = sp[(size_t)cc * DH]; carry = ab.x * carry + ab.y; }
        cs[tid] = carry;
        if (c == NCH - 1) { const f32x2 ab = sp[(size_t)c * DH]; F.out[OUT_HP + (size_t)b * DH + tid] = ab.x * carry + ab.y; }
    }
    __syncthreads();
    const int chunk = tid & 63, rsub = tid >> 6, col = chunk * 8, hd = chunk >> 3;
    for (int ps = 0; ps < 8; ++ps) {
        const size_t grow = (size_t)b * SEQ + 64 * c + ps * 8 + rsub;
        {
            const f32x2 ml0 = *(const f32x2*)(F.ML + ((0 * (size_t)MP + grow) * NH + hd) * 2), ml1 = *(const f32x2*)(F.ML + ((1 * (size_t)MP + grow) * NH + hd) * 2), ml2 = *(const f32x2*)(F.ML + ((2 * (size_t)MP + grow) * NH + hd) * 2);
            const float M = fmaxf(fmaxf(ml0.x, ml1.x), ml2.x);
            float w0 = ml0.y * fast_exp2(ml0.x - M), w1 = ml1.y * fast_exp2(ml1.x - M), w2 = ml2.y * fast_exp2(ml2.x - M);
            const float inv = 1.0f / (w0 + w1 + w2); w0 *= inv; w1 *= inv; w2 *= inv;
            const v4u a = *(const v4u*)(F.O0 + grow * DH + col), bq = *(const v4u*)(F.O1 + grow * DH + col), cq = *(const v4u*)(F.O2 + grow * DH + col), gt = *(const v4u*)(F.GAb + grow * DH + col);
            v4u o;
            o.x = pg8::cvt_pk_bf16((w0 * bflo(a.x) + w1 * bflo(bq.x) + w2 * bflo(cq.x)) * bflo(gt.x), (w0 * bfhi(a.x) + w1 * bfhi(bq.x) + w2 * bfhi(cq.x)) * bfhi(gt.x));
            o.y = pg8::cvt_pk_bf16((w0 * bflo(a.y) + w1 * bflo(bq.y) + w2 * bflo(cq.y)) * bflo(gt.y), (w0 * bfhi(a.y) + w1 * bfhi(bq.y) + w2 * bfhi(cq.y)) * bfhi(gt.y));
            o.z = pg8::cvt_pk_bf16((w0 * bflo(a.z) + w1 * bflo(bq.z) + w2 * bflo(cq.z)) * bflo(gt.z), (w0 * bfhi(a.z) + w1 * bfhi(bq.z) + w2 * bfhi(cq.z)) * bfhi(gt.z));
            o.w = pg8::cvt_pk_bf16((w0 * bflo(a.w) + w1 * bflo(bq.w) + w2 * bflo(cq.w)) * bflo(gt.w), (w0 * bfhi(a.w) + w1 * bfhi(bq.w) + w2 * bfhi(cq.w)) * bfhi(gt.w));
            *(v4u*)(F.MIX + grow * DM + col) = o;
        }
        {
            const v4u hl = *(const v4u*)(F.HL + grow * DH + col), pp = *(const v4u*)(F.PP + grow * DH + col), gt = *(const v4u*)(F.GLb + grow * DH + col);
            const f32x4 c0 = *(const LAS f32x4*)(cs + col), c1 = *(const LAS f32x4*)(cs + col + 4);
            v4u o;
            o.x = pg8::cvt_pk_bf16((bflo(hl.x) + bflo(pp.x) * c0[0]) * bflo(gt.x), (bfhi(hl.x) + bfhi(pp.x) * c0[1]) * bfhi(gt.x));
            o.y = pg8::cvt_pk_bf16((bflo(hl.y) + bflo(pp.y) * c0[2]) * bflo(gt.y), (bfhi(hl.y) + bfhi(pp.y) * c0[3]) * bfhi(gt.y));
            o.z = pg8::cvt_pk_bf16((bflo(hl.z) + bflo(pp.z) * c1[0]) * bflo(gt.z), (bfhi(hl.z) + bfhi(pp.z) * c1[1]) * bfhi(gt.z));
            o.w = pg8::cvt_pk_bf16((bflo(hl.w) + bflo(pp.w) * c1[2]) * bflo(gt.w), (bfhi(hl.w) + bfhi(pp.w) * c1[3]) * bfhi(gt.w));
            *(v4u*)(F.MIX + grow * DM + DH + col) = o;
        }
    }
    __syncthreads();
}

__device__ __forceinline__ void ln_row(Frame& F, int row) {
    const f32x4* zr = (const f32x4*)(F.Z + (size_t)row * DM) + F.lane;
    f32x4 v[4]; float s = 0.f;
#pragma unroll
    for (int j = 0; j < 4; ++j) { v[j] = zr[64 * j]; s += (v[j][0] + v[j][1]) + (v[j][2] + v[j][3]); }
    const float mean = wave_sum(s) * (1.f / DM); float s2 = 0.f;
#pragma unroll
    for (int j = 0; j < 4; ++j) { v[j] = v[j] - mean; s2 += (v[j][0] * v[j][0] + v[j][1] * v[j][1]) + (v[j][2] * v[j][2] + v[j][3] * v[j][3]); }
    const float rstd = 1.f / sqrtf(wave_sum(s2) * (1.f / DM) + LN_EPS);
    float* orow = row < MP ? F.out + OUT_YP + (size_t)row * DM : F.out + OUT_YS + (size_t)(row - MP) * DM;
#pragma unroll
    for (int j = 0; j < 4; ++j) { const f32x4 g = ((const f32x4*)F.ln_g)[F.lane + 64 * j], bb = ((const f32x4*)F.ln_b)[F.lane + 64 * j]; ((f32x4*)orow)[F.lane + 64 * j] = v[j] * rstd * g + bb; }
}

struct Args { const float* in[17]; float* out; unsigned char* ws; };
__global__ void __launch_bounds__(NWAVES * 64, 2) mk_fwd(Args args) {
    extern __shared__ __attribute__((aligned(16))) unsigned char lds[];
    Frame F;
    F.lds = (LAS unsigned char*)lds;
    F.MISC = (volatile LAS unsigned*)(F.lds + MISC_OFF);
    F.tid = threadIdx.x; F.lane = F.tid & 63; F.wave = __builtin_amdgcn_readfirstlane(F.tid >> 6); F.G = gridDim.x;
    unsigned char* ws = args.ws;
    F.ctl = (gu32*)(ws + WS_CTL);
    F.xp = args.in[0]; F.xs = args.in[1]; F.ck = args.in[2]; F.cv = args.in[3]; F.sconv = args.in[4]; F.sh = args.in[5]; F.w_in = args.in[6]; F.conv_w = args.in[7]; F.conv_b = args.in[8];
    F.w_ra = args.in[9]; F.b_ra = args.in[10]; F.w_ri = args.in[11]; F.b_ri = args.in[12]; F.lam = args.in[13]; F.w_out = args.in[14]; F.ln_g = args.in[15]; F.ln_b = args.in[16];
    F.out = args.out;
    F.WG = (bf16*)(ws + WS_WG); F.SP8 = (float*)(ws + WS_SP8);
    F.WinT = (bf16*)(ws + WS_WIN); F.WoutT = (bf16*)(ws + WS_WOUT); F.XB = (bf16*)(ws + WS_XB);
    F.Qb = (bf16*)(ws + WS_Q); F.Kb = (bf16*)(ws + WS_K); F.Vb = (bf16*)(ws + WS_V); F.GAb = (bf16*)(ws + WS_GA); F.XLb = (bf16*)(ws + WS_XL); F.GLb = (bf16*)(ws + WS_GL);
    F.O0 = (bf16*)(ws + WS_O0); F.O1 = (bf16*)(ws + WS_O1); F.O2 = (bf16*)(ws + WS_O2); F.ML = (float*)(ws + WS_ML);
    F.HL = (bf16*)(ws + WS_HL); F.PP = (bf16*)(ws + WS_PP); F.SUM = (float*)(ws + WS_SUM); F.Q2f = (float*)(ws + WS_Q2F); F.MIX = (bf16*)(ws + WS_MIX); F.Z = (float*)(ws + WS_Z);
    for (int u = F.tid; u < (LDS_BYTES - MISC_OFF) / 4; u += NWAVES * 64) ((LAS unsigned*)(F.lds + MISC_OFF))[u] = 0u;
    __syncthreads();
    XcdBarrier bar = xcd_barrier_post((unsigned*)(F.ctl + CW_BAR), F.MISC + 8);
    const int bid = blockIdx.x, G = F.G;

#ifndef NO_P0
    p0_prologue(F);
#endif
    xcd_barrier(bar);

#ifndef NO_P1
    {
        pg8::Gemm g{F.XB, F.WinT, MT, DIN, DM}; pg8::StaticOrder S; S.init(MT, DIN, G, bid);
        EpiProj E{F.Qb, F.Kb, F.Vb, F.GAb, F.XLb, F.GLb, F.Q2f, F.out};
        pg8::gemm_phase<EpiProj, pg8::StaticOrder, true, true>(F.lds, g, S, E);
    }
#endif
    xcd_barrier(bar);

#ifndef NO_LRU
    for (int u = bid; u < NB * NCH; u += G) lru_unit(F, u / NCH, u % NCH);
#endif
    __syncthreads();
#ifndef NO_SMP
    for (int u = bid; u < SB; u += G) sample_unit(F, u);
#endif
#ifndef NO_ATT
    for (int u = bid; u < 3 * 512; u += G) {
        const int pat = u >> 9, rem = u & 511, bh = rem >> 4, sub = rem & 15;
        const int d = pat == 0 ? 1 : pat == 1 ? 4 : 16, nqb = 16 / d;
        bf16* Od = pat == 0 ? F.O0 : pat == 1 ? F.O1 : F.O2;
        attn_unit(F, F.Qb, F.Kb, F.Vb, Od, F.ML + (size_t)pat * MP * NH * 2, d, bh >> 3, bh & 7, sub / nqb, sub % nqb);
    }
#endif
    xcd_barrier(bar);

#ifndef NO_MIX
    for (int u = bid; u < NB * NCH; u += G) mix_unit(F, u / NCH, u % NCH);
#endif
    xcd_barrier(bar);

#ifndef NO_P4
    {
        pg8::Gemm g{F.MIX, F.WoutT, MT, DM, DM}; pg8::StaticOrder S; S.init(MT, DM, G, bid);
        EpiZ E{F.xp, F.xs, F.Z};
        pg8::gemm_phase<EpiZ, pg8::StaticOrder, true, true>(F.lds, g, S, E);
    }
#endif
    xcd_barrier(bar);

    for (int row = bid * NWAVES + F.wave; row < MT; row += G * NWAVES) ln_row(F, row);
}

extern "C" void kernel_launch(void* const* d_in, const int* in_sizes, int n_in, void* d_out, int out_size, void* d_ws, size_t ws_size, hipStream_t stream) {
    static int grid = 0;
    if (grid == 0) {
        if (n_in != 17 || in_sizes[0] != MP * DM || (size_t)out_size != OUT_END || ws_size < WS_END) {
            fprintf(stderr, "kernel_launch: unexpected shapes (n_in %d, in0 %d, out %d, ws %zu); nothing launched\n", n_in, n_in > 0 ? in_sizes[0] : -1, out_size, ws_size); grid = -1; return; }
        int dev = 0, cus = 0, per_cu = 0;
        if (hipGetDevice(&dev) != hipSuccess || hipDeviceGetAttribute(&cus, hipDeviceAttributeMultiprocessorCount, dev) != hipSuccess) { grid = -1; return; }
        if (hipFuncSetAttribute((const void*)mk_fwd, hipFuncAttributeMaxDynamicSharedMemorySize, LDS_BYTES) != hipSuccess) { fprintf(stderr, "kernel_launch: hipFuncSetAttribute failed\n"); grid = -1; return; }
        if (hipOccupancyMaxActiveBlocksPerMultiprocessor(&per_cu, (const void*)mk_fwd, NWAVES * 64, LDS_BYTES) != hipSuccess || per_cu < 1)
            fprintf(stderr, "kernel_launch: note: occupancy query reports %d workgroups per CU\n", per_cu);
        (void)hipGetLastError();
        grid = cus;
    }
    if (grid < 0) return;
    if (hipMemsetAsync((char*)d_ws + WS_CTL, 0, CTL_ZERO_BYTES, stream) != hipSuccess) return;
    Args a{};
    for (int i = 0; i < 17; ++i) a.in[i] = (const float*)d_in[i];
    a.out = (float*)d_out; a.ws = (unsigned char*)d_ws;
    hipLaunchKernelGGL(mk_fwd, dim3(grid), dim3(NWAVES * 64), LDS_BYTES, stream, a);
}
```

```cpp
#include <hip/hip_runtime.h>
#include <cstdio>
#include <cstdint>

namespace pg8 {
#define PG8_LAS __attribute__((address_space(3)))
typedef unsigned short bf16_t;
typedef short bf16x8 __attribute__((ext_vector_type(8)));
typedef float f32x4 __attribute__((ext_vector_type(4)));
typedef unsigned u32x4 __attribute__((ext_vector_type(4)));
constexpr int BM = 256, BK = 64, HALF = 128, HTB = HALF * BK * 2  , STAGE_BYTES = 8 * HTB, NXCD = 8, WGM = 8;

__host__ __device__ __forceinline__ int lds_byte(int r, int c) { const int st = (r >> 4) * 2 + (c >> 5), rr = r & 15, cc = c & 31, ob = rr * 64 + cc * 2; return st * 1024 + (ob ^ (((ob >> 9) & 1) << 5)); }
__host__ __device__ __forceinline__ void stage_rc(int b, int& R, int& C) { const int st = b / 1024, sb = b % 1024, swz = sb ^ (((sb >> 9) & 1) << 5); R = (st >> 1) * 16 + swz / 64; C = (st & 1) * 32 + (swz % 64) / 2; }
__host__ __device__ __forceinline__ int perm32(int rho) { const int n = rho >> 4, i = rho & 15; return 8 * (i >> 2) + 4 * n + (i & 3); }

struct Unit { int pm, pn; };
struct Gemm { const bf16_t* A; const bf16_t* Bt; int M, N, K; };

struct StaticOrder {
    int nM, nN, nwg, G, c;
    __host__ __device__ void init(int M, int N, int G_, int c_) { nM = M / BM; nN = N / BM; nwg = nM * nN; G = G_; c = c_; }
    __host__ __device__ bool next(int i, Unit& u) const {
        const long L = (long)i * G + c; if (L >= nwg) return false;
        int wgid = (int)L; { const int q = nwg / NXCD, r = nwg % NXCD, xcd = wgid % NXCD, off = wgid / NXCD; wgid = (xcd < r ? xcd * (q + 1) : r * (q + 1) + (xcd - r) * q) + off; }
        const int nig = WGM * nN, gid = wgid / nig, fm = gid * WGM, gsz = (nM - fm) < WGM ? (nM - fm) : WGM;
        u.pm = fm + ((wgid % nig) % gsz); u.pn = (wgid % nig) / gsz; return true;
    }
    __device__ __forceinline__ void a_ready(const Unit&) const {}
    __device__ __forceinline__ void done(const Unit&) const {}
};

__device__ __forceinline__ unsigned cvt_pk_bf16(float lo, float hi) { unsigned r; asm volatile("v_cvt_pk_bf16_f32 %0, %1, %2" : "=v"(r) : "v"(lo), "v"(hi)); return r; }
typedef float f32x2 __attribute__((ext_vector_type(2)));
__device__ __forceinline__ f32x2 gelu_pk(f32x2 v) {
    const f32x2 av = __builtin_elementwise_abs(v), d = av * 0.2316418882f + 1.0f;
    f32x2 t; t.x = __builtin_amdgcn_rcpf(d.x); t.y = __builtin_amdgcn_rcpf(d.y);
    f32x2 q = t * 0.5307027145f + (-0.7265760135f); q = q * t + 0.7107068705f; q = q * t + (-0.142248368f); q = q * t + 0.127414796f; q = q * t;
    const f32x2 s = (v * v) * (-0.72134752044f);
    f32x2 e; e.x = __builtin_amdgcn_exp2f(s.x); e.y = __builtin_amdgcn_exp2f(s.y);
    const f32x2 m = v * (q * e), r = v - m;
    f32x2 o; o.x = v.x < 0.f ? m.x : r.x; o.y = v.y < 0.f ? m.y : r.y; return o;
}

template <int ACT  > struct EpiBf16 {
    static constexpr bool PERM = true, AFTER_DRAIN = false; static_assert(ACT == 0 || ACT == 1, "EpiBf16: ACT is 0 (none) or 1 (gelu_pk)");
    bf16_t* O; int ldc; const float* bias; int split_cols; size_t split_stride; float scale0;
    __device__ __forceinline__ void operator()(const f32x4 (&acc)[2][2][4][2], const Unit& u, int wr, int wc, int fr, int fq) const {
        const int row0 = u.pm * BM + wr * 64 + fr; int colt = u.pn * BM; bf16_t* base = O;
        float sc = 1.f; if (split_cols) { const int t = colt / split_cols; base += (size_t)t * split_stride; colt -= t * split_cols; if (t == 0) sc = scale0; }
        const int col0 = colt + wc * 32 + 8 * fq, bcol0 = u.pn * BM + wc * 32 + 8 * fq;
        f32x4 bv[2][2];
#pragma unroll
        for (int bj = 0; bj < 2; ++bj)
#pragma unroll
            for (int n = 0; n < 2; ++n) bv[bj][n] = bias ? *(const f32x4*)(bias + bcol0 + bj * HALF + 4 * n) : (f32x4){0.f, 0.f, 0.f, 0.f};
#pragma unroll
        for (int ai = 0; ai < 2; ++ai)
#pragma unroll
            for (int m = 0; m < 4; ++m) { bf16_t* rowp = base + (size_t)(row0 + ai * HALF + m * 16) * ldc + col0;
#pragma unroll
                for (int bj = 0; bj < 2; ++bj) { f32x4 v0 = acc[ai][bj][m][0] + bv[bj][0], v1 = acc[ai][bj][m][1] + bv[bj][1];
                    if (ACT == 1) { f32x2 a = gelu_pk((f32x2){v0[0], v0[1]}), b = gelu_pk((f32x2){v0[2], v0[3]}), c = gelu_pk((f32x2){v1[0], v1[1]}), d = gelu_pk((f32x2){v1[2], v1[3]});
                        v0 = (f32x4){a.x, a.y, b.x, b.y}; v1 = (f32x4){c.x, c.y, d.x, d.y}; }
                    v0 = v0 * sc; v1 = v1 * sc; u32x4 w; w.x = cvt_pk_bf16(v0[0], v0[1]); w.y = cvt_pk_bf16(v0[2], v0[3]); w.z = cvt_pk_bf16(v1[0], v1[1]); w.w = cvt_pk_bf16(v1[2], v1[3]);
                    *(u32x4*)(rowp + bj * HALF) = w; } }
    }
};

struct PanelStats {
    unsigned* xbuf;
    unsigned* cnt;
    unsigned* tmo;
    int ntn; float eps;
    unsigned code;
    __device__ __forceinline__ bool run(const f32x4 (&v)[2][2][4][2], const Unit& u, int wr, int wc, int fr, int fq, PG8_LAS unsigned char* lds, int wid, int lane) const {
        typedef float f32x2v __attribute__((ext_vector_type(2)));
        PG8_LAS f32x2v* P = (PG8_LAS f32x2v*)lds;
        PG8_LAS f32x2v* S = (PG8_LAS f32x2v*)(lds + 8192);
        PG8_LAS unsigned* flag = (PG8_LAS unsigned*)(lds + 8192 + 2048);
#pragma unroll
        for (int ai = 0; ai < 2; ++ai)
#pragma unroll
            for (int m = 0; m < 4; ++m) {
                float s = 0.f;
#pragma unroll
                for (int bj = 0; bj < 2; ++bj)
#pragma unroll
                    for (int n = 0; n < 2; ++n) { const f32x4 x = v[ai][bj][m][n]; s += (x[0] + x[1]) + (x[2] + x[3]); }
                s += __shfl_xor(s, 16); s += __shfl_xor(s, 32);
                const float mw = s * (1.0f / 64.0f); float q = 0.f;
#pragma unroll
                for (int bj = 0; bj < 2; ++bj)
#pragma unroll
                    for (int n = 0; n < 2; ++n) { const f32x4 d = v[ai][bj][m][n] - mw; q += (d[0] * d[0] + d[1] * d[1]) + (d[2] * d[2] + d[3] * d[3]); }
                q += __shfl_xor(q, 16); q += __shfl_xor(q, 32);
                if (fq == 0) P[(ai * HALF + wr * 64 + m * 16 + fr) * 4 + wc] = (f32x2v){mw, q};
            }
        asm volatile("s_waitcnt lgkmcnt(0)" ::: "memory"); __builtin_amdgcn_s_barrier(); asm volatile("" ::: "memory");
#if defined(BROKEN_EXCHANGE_NO_WAIT)
#warning BROKEN CONTROL BUILD: the row-statistics exchange does not wait; results are wrong by design
        if (blockIdx.x >= 64) { const long long t0_ = clock64(); while (clock64() - t0_ < 60000) __builtin_amdgcn_s_sleep(8); }
#endif
        const int row = wid * 32 + (lane & 31);
        if (lane < 32) {
            const f32x2v a = P[row * 4 + 0], b = P[row * 4 + 1], c = P[row * 4 + 2], d = P[row * 4 + 3];
            const float mt = (a.x + b.x + c.x + d.x) * 0.25f;
            const float da = a.x - mt, db = b.x - mt, dc = c.x - mt, dd = d.x - mt;
            const float m2 = (a.y + b.y) + (c.y + d.y) + 64.0f * ((da * da + db * db) + (dc * dc + dd * dd));
            unsigned long long* slot = (unsigned long long*)xbuf + ((size_t)(u.pm * BM + row) * 4 + u.pn);
            __hip_atomic_store(slot, ((unsigned long long)__float_as_uint(m2) << 32) | __float_as_uint(mt), __ATOMIC_RELAXED, __HIP_MEMORY_SCOPE_AGENT);
        }
        asm volatile("s_waitcnt vmcnt(0)" ::: "memory");
        if (lane == 0) __hip_atomic_fetch_add(cnt + 64 * u.pm, 1u, __ATOMIC_RELAXED, __HIP_MEMORY_SCOPE_AGENT);
        if (wid == 0) {
            bool dead = false; const unsigned long long t0 = __builtin_amdgcn_s_memrealtime(); const unsigned want = 8u * (unsigned)ntn;
            for (;;) {
#if defined(BROKEN_EXCHANGE_NO_WAIT)
                break;
#endif
                if ((unsigned)__builtin_amdgcn_readfirstlane(__hip_atomic_load(cnt + 64 * u.pm, __ATOMIC_RELAXED, __HIP_MEMORY_SCOPE_AGENT)) >= want) break;
                if (__builtin_amdgcn_s_memrealtime() - t0 > 2000000ull) {
                    if (lane == 0) { unsigned expect = 0u; __hip_atomic_compare_exchange_strong(tmo + 1, &expect, code | (unsigned)(u.pm & 0xff), __ATOMIC_RELAXED, __ATOMIC_RELAXED, __HIP_MEMORY_SCOPE_AGENT);
                                     __hip_atomic_store(tmo, 1u, __ATOMIC_RELAXED, __HIP_MEMORY_SCOPE_AGENT); }
                    dead = true; break; }
                __builtin_amdgcn_s_sleep(2);
            }
            __builtin_amdgcn_fence(__ATOMIC_ACQUIRE, "agent");
            if (lane == 0) flag[0] = dead ? 1u : 0u;
        }
        asm volatile("s_waitcnt vmcnt(0) lgkmcnt(0)" ::: "memory"); __builtin_amdgcn_s_barrier(); asm volatile("" ::: "memory");
        const bool bad = flag[0] != 0u;
        if (lane < 32) {
            const unsigned long long* slot = (const unsigned long long*)xbuf + (size_t)(u.pm * BM + row) * 4; float mt[4], m2[4]; float ms = 0.f;
#pragma unroll
            for (int t = 0; t < 4; ++t) { if (t < ntn) { const unsigned long long w = __hip_atomic_load(slot + t, __ATOMIC_RELAXED, __HIP_MEMORY_SCOPE_AGENT); mt[t] = __uint_as_float((unsigned)w); m2[t] = __uint_as_float((unsigned)(w >> 32)); } else { mt[t] = 0.f; m2[t] = 0.f; } ms += mt[t]; }
            const float mean = ms / (float)ntn; float q = 0.f;
#pragma unroll
            for (int t = 0; t < 4; ++t) if (t < ntn) { const float dm = mt[t] - mean; q += m2[t] + 256.0f * dm * dm; }
            S[row] = (f32x2v){mean, 1.0f / sqrtf(q / (256.0f * (float)ntn) + eps)};
        }
        asm volatile("s_waitcnt lgkmcnt(0)" ::: "memory"); __builtin_amdgcn_s_barrier(); asm volatile("" ::: "memory");
        return bad;
    }
};
struct EpiLnRes {
    static constexpr bool PERM = false, AFTER_DRAIN = true;
    const float* base; float* out; int ldc; const float* bias; PanelStats st; unsigned poison;
    __device__ __forceinline__ void fused(f32x4 (&acc)[2][2][4][2], const Unit& u, int wr, int wc, int fr, int fq, PG8_LAS unsigned char* lds, int wid, int lane) const {
        typedef float f32x2v __attribute__((ext_vector_type(2)));
        const PG8_LAS f32x2v* S = (const PG8_LAS f32x2v*)(lds + 8192);
        const int col0 = u.pn * BM + wc * 32 + 4 * fq;
#pragma unroll
        for (int bj = 0; bj < 2; ++bj)
#pragma unroll
            for (int n = 0; n < 2; ++n) { const f32x4 bv = bias ? *(const f32x4*)(bias + col0 + bj * HALF + n * 16) : (f32x4){0.f, 0.f, 0.f, 0.f};
#pragma unroll
                for (int ai = 0; ai < 2; ++ai)
#pragma unroll
                    for (int m = 0; m < 4; ++m) acc[ai][bj][m][n] += bv; }
        f32x4 pre[4][2][2];
#pragma unroll
        for (int m = 0; m < 4; ++m) { const size_t off = (size_t)(u.pm * BM + wr * 64 + m * 16 + fr) * ldc + col0;
#pragma unroll
            for (int bj = 0; bj < 2; ++bj)
#pragma unroll
                for (int n = 0; n < 2; ++n) pre[m][bj][n] = *(const f32x4*)(base + off + bj * HALF + n * 16); }
        const bool bad = st.run(acc, u, wr, wc, fr, fq, lds, wid, lane) || poison != 0u;
        const float qnan = __builtin_nanf("");
#pragma unroll
        for (int ai = 0; ai < 2; ++ai)
#pragma unroll
            for (int m = 0; m < 4; ++m) { const int r = ai * HALF + wr * 64 + m * 16 + fr; const f32x2v sr = S[r]; const size_t off = (size_t)(u.pm * BM + r) * ldc + col0;
#pragma unroll
                for (int bj = 0; bj < 2; ++bj)
#pragma unroll
                    for (int n = 0; n < 2; ++n) { const f32x4 bs = ai == 0 ? pre[m][bj][n] : *(const f32x4*)(base + off + bj * HALF + n * 16); f32x4 o = bs + (acc[ai][bj][m][n] - sr.x) * sr.y;
                        if (bad) o = (f32x4){qnan, qnan, qnan, qnan}; *(f32x4*)(out + off + bj * HALF + n * 16) = o; }
                if (m & 1) asm volatile("" ::: "memory"); }
    }
};
struct EpiLnResLn {
    static constexpr bool PERM = false, AFTER_DRAIN = true;
    const float* base; float* out; bf16_t* xn; int ldc; const float* bias; PanelStats st1, st2; unsigned poison;
    __device__ __forceinline__ void fused(f32x4 (&acc)[2][2][4][2], const Unit& u, int wr, int wc, int fr, int fq, PG8_LAS unsigned char* lds, int wid, int lane) const {
        typedef float f32x2v __attribute__((ext_vector_type(2))); typedef unsigned u32x2v __attribute__((ext_vector_type(2)));
        const PG8_LAS f32x2v* S = (const PG8_LAS f32x2v*)(lds + 8192);
        const int col0 = u.pn * BM + wc * 32 + 4 * fq;
#pragma unroll
        for (int bj = 0; bj < 2; ++bj)
#pragma unroll
            for (int n = 0; n < 2; ++n) { const f32x4 bv = bias ? *(const f32x4*)(bias + col0 + bj * HALF + n * 16) : (f32x4){0.f, 0.f, 0.f, 0.f};
#pragma unroll
                for (int ai = 0; ai < 2; ++ai)
#pragma unroll
                    for (int m = 0; m < 4; ++m) acc[ai][bj][m][n] += bv; }
        bool bad = st1.run(acc, u, wr, wc, fr, fq, lds, wid, lane) || poison != 0u;
        const float qnan = __builtin_nanf("");
#pragma unroll
        for (int ai = 0; ai < 2; ++ai)
#pragma unroll
            for (int m = 0; m < 4; ++m) { const int r = ai * HALF + wr * 64 + m * 16 + fr; const f32x2v sr = S[r]; const size_t off = (size_t)(u.pm * BM + r) * ldc + col0;
#pragma unroll
                for (int bj = 0; bj < 2; ++bj)
#pragma unroll
                    for (int n = 0; n < 2; ++n) { const f32x4 bs = *(const f32x4*)(base + off + bj * HALF + n * 16); acc[ai][bj][m][n] = bs + (acc[ai][bj][m][n] - sr.x) * sr.y; }
                asm volatile("" : "+v"(acc[ai][0][m][0]), "+v"(acc[ai][0][m][1]), "+v"(acc[ai][1][m][0]), "+v"(acc[ai][1][m][1]));
                if (m & 1) asm volatile("" ::: "memory"); }
        const bool bad1 = bad;
        bad = st2.run(acc, u, wr, wc, fr, fq, lds, wid, lane) || bad;
#pragma unroll
        for (int ai = 0; ai < 2; ++ai)
#pragma unroll
            for (int m = 0; m < 4; ++m) { const int r = ai * HALF + wr * 64 + m * 16 + fr; const f32x2v sr = S[r]; const size_t off = (size_t)(u.pm * BM + r) * ldc + col0;
#pragma unroll
                for (int bj = 0; bj < 2; ++bj)
#pragma unroll
                    for (int n = 0; n < 2; ++n) { const f32x4 x1 = acc[ai][bj][m][n]; *(f32x4*)(out + off + bj * HALF + n * 16) = bad1 ? (f32x4){qnan, qnan, qnan, qnan} : x1;
                        const f32x4 o = (x1 - sr.x) * sr.y; u32x2v w; w.x = cvt_pk_bf16(o[0], o[1]); w.y = cvt_pk_bf16(o[2], o[3]);
                        if (bad) { w.x = 0x7fc07fc0u; w.y = 0x7fc07fc0u; } *(u32x2v*)(xn + off + bj * HALF + n * 16) = w; }
                asm volatile("" ::: "memory"); }
    }
};

template <class Epi, class Sched, bool ALIGN_EPI = false, bool SP2 = false>
__device__ __forceinline__ void gemm_phase(PG8_LAS unsigned char* lds, const Gemm g, const Sched& S, const Epi& E) {
    int tid_ = threadIdx.x; asm volatile("" : "+v"(tid_));
    const int tid = tid_, wid = __builtin_amdgcn_readfirstlane(tid >> 6), lane = tid & 63, wr = wid >> 2, wc = wid & 3, fr = lane & 15, fq = lane >> 4;
    const int K = g.K, nt = K / BK;
    unsigned voffA[2], voffB[2];
#pragma unroll
    for (int i = 0; i < 2; ++i) { int R, C; stage_rc(tid * 16 + i * 8192, R, C); const int Rb = Epi::PERM ? ((R & ~31) + perm32(R & 31)) : R;
        voffA[i] = (unsigned)(R * K + C) * 2u; voffB[i] = (unsigned)(Rb * K + C) * 2u; }
    const size_t kstep = (size_t)(BK * 2);
    const size_t hstep = (size_t)HALF * K * 2;
    const size_t tstep = 2 * hstep;
    const unsigned ldsw = (unsigned)wid * 1024u;
    const int aoff = lds_byte(wr * 64 + fr, fq * 8), boff = lds_byte(wc * 32 + fr, fq * 8);
#define PG8_SA(b, h) (((b) * 2 + (h)) * HTB)
#define PG8_SB(b, h) ((4 + (b) * 2 + (h)) * HTB)
#define PG8_STAGE(bufoff, gbase, voff) do { _Pragma("unroll") for (int _i = 0; _i < 2; ++_i) \
        __builtin_amdgcn_global_load_lds((const unsigned*)((const char*)(gbase) + (voff)[_i]), (PG8_LAS unsigned*)(lds + (bufoff) + ldsw + _i * 8192), 16, 0, 0); } while (0)
#define PG8_LDA(dst, b, h) do { _Pragma("unroll") for (int m = 0; m < 4; ++m) _Pragma("unroll") for (int k = 0; k < 2; ++k) dst[m][k] = *(const PG8_LAS bf16x8*)(lds + PG8_SA(b, h) + aoff + m * 2048 + k * 1024); } while (0)
#define PG8_LDB(dst, b, h) do { _Pragma("unroll") for (int n = 0; n < 2; ++n) _Pragma("unroll") for (int k = 0; k < 2; ++k) dst[n][k] = *(const PG8_LAS bf16x8*)(lds + PG8_SB(b, h) + boff + n * 2048 + k * 1024); } while (0)
#define PG8_MMA(ai, bj, At, Bt) do { __builtin_amdgcn_s_setprio(1); _Pragma("unroll") for (int m = 0; m < 4; ++m) _Pragma("unroll") for (int n = 0; n < 2; ++n) _Pragma("unroll") for (int k = 0; k < 2; ++k) \
        acc[ai][bj][m][n] = __builtin_amdgcn_mfma_f32_16x16x32_bf16(Bt[n][k], At[m][k], acc[ai][bj][m][n], 0, 0, 0); __builtin_amdgcn_s_setprio(0); } while (0)
#define PG8_WAIT_V(n) asm volatile("s_waitcnt vmcnt(" #n ")" ::: "memory")
#define PG8_WAIT_L(n) asm volatile("s_waitcnt lgkmcnt(" #n ")" ::: "memory")
#define PG8_BAR __builtin_amdgcn_s_barrier()
#define PG8_SCHED __builtin_amdgcn_sched_barrier(0)
    Unit cur, nxt; int ui = 0;
    if (!S.next(0, cur)) return;
    f32x4 acc[2][2][4][2];
#pragma unroll
    for (int a = 0; a < 2; ++a)
#pragma unroll
        for (int b = 0; b < 2; ++b)
#pragma unroll
            for (int m = 0; m < 4; ++m)
#pragma unroll
                for (int n = 0; n < 2; ++n) acc[a][b][m][n] = (f32x4){0.f, 0.f, 0.f, 0.f};
    bf16x8 At[4][2], B0[2][2], B1[2][2];
    const char* cA = (const char*)g.A + (size_t)cur.pm * tstep; const char* cB = (const char*)g.Bt + (size_t)cur.pn * tstep;
    S.a_ready(cur);
    if constexpr (SP2) {
        PG8_STAGE(PG8_SB(0, 0), cB, voffB); PG8_STAGE(PG8_SB(0, 1), cB + hstep, voffB); PG8_STAGE(PG8_SA(0, 0), cA, voffA); PG8_STAGE(PG8_SA(0, 1), cA + hstep, voffA);
        if (wr == 1) PG8_BAR;
        PG8_WAIT_V(2); PG8_BAR;
        PG8_STAGE(PG8_SB(1, 0), cB + kstep, voffB); PG8_STAGE(PG8_SA(1, 0), cA + kstep, voffA); PG8_STAGE(PG8_SB(1, 1), cB + hstep + kstep, voffB);
        PG8_WAIT_V(6); PG8_BAR;
    } else {
        PG8_STAGE(PG8_SB(0, 0), cB, voffB); PG8_STAGE(PG8_SA(0, 0), cA, voffA); PG8_STAGE(PG8_SB(0, 1), cB + hstep, voffB); PG8_STAGE(PG8_SA(0, 1), cA + hstep, voffA);
        if (wr == 1) PG8_BAR;
        PG8_WAIT_V(4); PG8_BAR;
        PG8_STAGE(PG8_SB(1, 0), cB + kstep, voffB); PG8_STAGE(PG8_SA(1, 0), cA + kstep, voffA); PG8_STAGE(PG8_SB(1, 1), cB + hstep + kstep, voffB);
        PG8_WAIT_V(6); PG8_BAR;
    }
    for (;;) {
        const bool has_next = S.next(ui + 1, nxt);
        const char* nA = has_next ? (const char*)g.A + (size_t)nxt.pm * tstep : cA; const char* nB = has_next ? (const char*)g.Bt + (size_t)nxt.pn * tstep : cB;
        for (int t = 0; t < nt; t += 2) {
            const bool last = (t == nt - 2);
            const char* a1 = cA + (size_t)(t + 1) * kstep;
            const char* a2 = last ? nA : cA + (size_t)(t + 2) * kstep; const char* b2 = last ? nB : cB + (size_t)(t + 2) * kstep;
            const char* a3 = a2 + kstep; const char* b3 = b2 + kstep;
            if (last && has_next) S.a_ready(nxt);
            if constexpr (SP2) {
            PG8_LDB(B0, 0, 0); PG8_LDB(B1, 0, 1); PG8_SCHED; PG8_LDA(At, 0, 0); PG8_STAGE(PG8_SA(1, 1), a1 + hstep, voffA);
            PG8_WAIT_V(8); PG8_WAIT_L(0); PG8_BAR; PG8_MMA(0, 0, At, B0); PG8_MMA(0, 1, At, B1); PG8_BAR; PG8_SCHED;
            PG8_LDA(At, 0, 1); PG8_STAGE(PG8_SB(0, 0), b2, voffB); PG8_STAGE(PG8_SB(0, 1), b2 + hstep, voffB); PG8_STAGE(PG8_SA(0, 0), a2, voffA);
            PG8_WAIT_V(8); PG8_WAIT_L(0); PG8_BAR; PG8_MMA(1, 0, At, B0); PG8_MMA(1, 1, At, B1); PG8_BAR; PG8_SCHED;
            PG8_LDB(B0, 1, 0); PG8_LDB(B1, 1, 1); PG8_SCHED; PG8_LDA(At, 1, 0); PG8_STAGE(PG8_SA(0, 1), a2 + hstep, voffA);
            PG8_WAIT_V(8); PG8_WAIT_L(0); PG8_BAR; PG8_MMA(0, 0, At, B0); PG8_MMA(0, 1, At, B1); PG8_BAR; PG8_SCHED;
            PG8_LDA(At, 1, 1); PG8_STAGE(PG8_SB(1, 0), b3, voffB); PG8_STAGE(PG8_SB(1, 1), b3 + hstep, voffB); PG8_STAGE(PG8_SA(1, 0), a3, voffA);
            PG8_WAIT_V(8); PG8_WAIT_L(0); PG8_BAR; PG8_MMA(1, 0, At, B0); PG8_MMA(1, 1, At, B1); PG8_BAR; PG8_SCHED;
            } else {
            PG8_LDB(B0, 0, 0); PG8_SCHED; PG8_LDA(At, 0, 0); PG8_STAGE(PG8_SA(1, 1), a1 + hstep, voffA);
            PG8_WAIT_L(8); PG8_BAR; PG8_WAIT_L(0); PG8_MMA(0, 0, At, B0); PG8_BAR; PG8_SCHED;
            PG8_LDB(B1, 0, 1); PG8_STAGE(PG8_SB(0, 0), b2, voffB);
            PG8_BAR; PG8_WAIT_L(0); PG8_MMA(0, 1, At, B1); PG8_BAR;
            PG8_LDA(At, 0, 1); PG8_STAGE(PG8_SA(0, 0), a2, voffA);
            PG8_BAR; PG8_WAIT_L(0); PG8_MMA(1, 0, At, B0); PG8_BAR; PG8_SCHED;
            PG8_STAGE(PG8_SB(0, 1), b2 + hstep, voffB);
            PG8_WAIT_V(6); PG8_BAR; PG8_MMA(1, 1, At, B1); PG8_BAR;
            PG8_LDB(B0, 1, 0); PG8_SCHED; PG8_LDA(At, 1, 0); PG8_STAGE(PG8_SA(0, 1), a2 + hstep, voffA);
            PG8_WAIT_L(8); PG8_BAR; PG8_WAIT_L(0); PG8_MMA(0, 0, At, B0); PG8_BAR; PG8_SCHED;
            PG8_LDB(B1, 1, 1); PG8_STAGE(PG8_SB(1, 0), b3, voffB);
            PG8_BAR; PG8_WAIT_L(0); PG8_MMA(0, 1, At, B1); PG8_BAR;
            PG8_LDA(At, 1, 1); PG8_STAGE(PG8_SA(1, 0), a3, voffA);
            PG8_BAR; PG8_WAIT_L(0); PG8_MMA(1, 0, At, B0); PG8_BAR; PG8_SCHED;
            PG8_STAGE(PG8_SB(1, 1), b3 + hstep, voffB);
            PG8_WAIT_V(6); PG8_BAR; PG8_MMA(1, 1, At, B1); PG8_BAR;
            }
        }
        if constexpr (ALIGN_EPI) { if (wr == 0) PG8_BAR; }
        if constexpr (!Epi::AFTER_DRAIN) { E(acc, cur, wr, wc, fr, fq); S.done(cur); }
        if (!has_next) break;
#pragma unroll
        for (int a = 0; a < 2; ++a)
#pragma unroll
            for (int b = 0; b < 2; ++b)
#pragma unroll
                for (int m = 0; m < 4; ++m)
#pragma unroll
                    for (int n = 0; n < 2; ++n) acc[a][b][m][n] = (f32x4){0.f, 0.f, 0.f, 0.f};
        cur = nxt; cA = nA; cB = nB; ++ui;
        if constexpr (ALIGN_EPI) { if (wr == 1) PG8_BAR; }
    }
    PG8_WAIT_V(0);
    if constexpr (!ALIGN_EPI) { if (wr == 0) PG8_BAR; }
    PG8_BAR;
    if constexpr (Epi::AFTER_DRAIN) { E.fused(acc, cur, wr, wc, fr, fq, lds, wid, lane); S.done(cur); }
#undef PG8_SA
#undef PG8_SB
#undef PG8_STAGE
#undef PG8_LDA
#undef PG8_LDB
#undef PG8_MMA
#undef PG8_WAIT_V
#undef PG8_WAIT_L
#undef PG8_BAR
#undef PG8_SCHED
}
}
#define GAS __attribute__((address_space(1)))
#define LAS __attribute__((address_space(3)))
typedef unsigned short bf16;
typedef unsigned v4u __attribute__((ext_vector_type(4)));
typedef float f32x4 __attribute__((ext_vector_type(4)));
typedef short bf16x8 __attribute__((ext_vector_type(8)));
typedef GAS unsigned gu32;
typedef GAS unsigned long long gu64;
#define RLX_AGENT __ATOMIC_RELAXED, __HIP_MEMORY_SCOPE_AGENT
#define LDS_WAIT() asm volatile("s_waitcnt lgkmcnt(0)" ::: "memory")
#define VM_WAIT() asm volatile("s_waitcnt vmcnt(0)" ::: "memory")
__device__ __forceinline__ unsigned long long rt() { return __builtin_amdgcn_s_memrealtime(); }
__device__ __forceinline__ unsigned f2bf(float f) { unsigned u = __builtin_bit_cast(unsigned, f); return (u + 0x7fffu + ((u >> 16) & 1u)) >> 16; }
__device__ __forceinline__ unsigned pk2(float lo, float hi) { return f2bf(lo) | (f2bf(hi) << 16); }

#define XB_TMO      128
#define XB_XCNT(j)  (256  + 64 * (j))
#define XB_XSUB(j)  (1280 + 64 * (j))
#define XB_XGEN(j)  (2304 + 64 * (j))
#define XB_TOP      3328
#define XB_TOPGEN   3392
#define XCD_BAR_WORDS 3456
#define XB_SPIN_CAP (1u << 18)

__device__ __forceinline__ unsigned xb_ld(unsigned* p)              { return __hip_atomic_load(p, __ATOMIC_RELAXED, __HIP_MEMORY_SCOPE_AGENT); }
__device__ __forceinline__ unsigned xb_add(unsigned* p, unsigned v) { return __hip_atomic_fetch_add(p, v, __ATOMIC_RELAXED, __HIP_MEMORY_SCOPE_AGENT); }
__device__ __forceinline__ unsigned xb_xcc_id() { return (unsigned)__builtin_amdgcn_s_getreg((3 << 11) | 20) & 0xFu; }
#define XB_SPIN(cond, bar) do { unsigned _sp = 0; while (cond) { __builtin_amdgcn_s_sleep(1); \
    if ((++_sp & 255u) == 0u) { if (xb_ld(&(bar)[XB_TMO])) break; if (_sp > XB_SPIN_CAP) { atomicAdd(&(bar)[XB_TMO], 1u); break; } } } } while (0)

struct XcdBarrier {
    unsigned* bar; unsigned x;
    volatile LAS unsigned* st;
};

__device__ __forceinline__ XcdBarrier xcd_barrier_post(unsigned* bar, volatile LAS unsigned* st) {
    XcdBarrier b; b.bar = bar; b.x = xb_xcc_id(); b.st = st;
    if (threadIdx.x == 0) (void)xb_add(&bar[XB_XCNT(b.x)], 1u);
    return b;
}
__device__ __forceinline__ void xcd_barrier_complete(unsigned* bar, unsigned x, unsigned& nloc, unsigned& nx) {
    const unsigned G = gridDim.x * gridDim.y * gridDim.z;
    unsigned sum, cnt, mine, sp = 0u;
    for (;;) {
        sum = 0u; cnt = 0u; mine = 0u;
#pragma unroll
        for (unsigned j = 0; j < 16; ++j) { const unsigned c = xb_ld(&bar[XB_XCNT(j)]); sum += c; cnt += (c > 0u) ? 1u : 0u; mine = (j == x) ? c : mine; }
        if (sum == G) break;
        __builtin_amdgcn_s_sleep(1);
        if ((++sp & 255u) == 0u) { if (xb_ld(&bar[XB_TMO])) break; if (sp > XB_SPIN_CAP) { atomicAdd(&bar[XB_TMO], 1u); break; } }
    }
    nloc = mine > 0u ? mine : 1u; nx = cnt > 0u ? cnt : 1u;
}

__device__ __forceinline__ void xcd_barrier(const XcdBarrier& b) {
    asm volatile("s_waitcnt vmcnt(0)" ::: "memory");
    __syncthreads();
    if (threadIdx.x == 0) {
        unsigned* bar = b.bar;
        __builtin_amdgcn_s_waitcnt(0);
        unsigned nloc = b.st[0], nx = b.st[1];
        if (nloc == 0u) { xcd_barrier_complete(bar, b.x, nloc, nx); b.st[0] = nloc; b.st[1] = nx; }
        const unsigned old = xb_add(&bar[XB_XSUB(b.x)], 1u);
        const unsigned gen = old / nloc;
        if (old + 1u == (gen + 1u) * nloc) {
            __builtin_amdgcn_fence(__ATOMIC_RELEASE, "agent");
            asm volatile("s_waitcnt vmcnt(0)" ::: "memory");
            const unsigned og = xb_add(&bar[XB_TOP], 1u);
            const unsigned tg = og / nx;
            if (og + 1u == (tg + 1u) * nx) xb_add(&bar[XB_TOPGEN], 1u);
            else XB_SPIN(xb_ld(&bar[XB_TOPGEN]) == tg, bar);
            __builtin_amdgcn_fence(__ATOMIC_ACQUIRE, "agent");
            xb_add(&bar[XB_XGEN(b.x)], 1u);
            asm volatile("s_waitcnt vmcnt(0)" ::: "memory");
        } else {
            XB_SPIN(xb_ld(&bar[XB_XGEN(b.x)]) == gen, bar);
            __builtin_amdgcn_fence(__ATOMIC_ACQUIRE, "agent");
            asm volatile("s_waitcnt vmcnt(0)" ::: "memory");
        }
    }
    __syncthreads();
}
#ifndef REP_P0
#define REP_P0 1
#endif
#ifndef REP_LRU
#define REP_LRU 1
#endif
#ifndef REP_SMP
#define REP_SMP 1
#endif
#ifndef REP_ATT
#define REP_ATT 1
#endif
#ifndef REP_MIX
#define REP_MIX 1
#endif
#ifndef REP_P1
#define REP_P1 1
#endif
#ifndef REP_P4
#define REP_P4 1
#endif
#ifndef REP_LN
#define REP_LN 1
#endif
constexpr int NWAVES = 8;
constexpr int DM = 1024, SEQ = 4096, NB = 4, MP = NB * SEQ, SB = 128, ST = 4, MS = SB * ST, MT = MP + MS;
constexpr int DH = 512, NH = 8, HD = 64, DIN = 3072, WBUF = 2048;
constexpr int NCH = SEQ / 64;
constexpr float LN_EPS = 1e-5f;
constexpr float ALPHA = 1.1892071150027210667f;
constexpr float LOG2E = 1.4426950408889634f;
constexpr float QSCALE = 0.125f * LOG2E;
constexpr float NEGBIG = -1.0e30f;
constexpr size_t OUT_YP = 0, OUT_YS = 16777216, OUT_KP = 17301504, OUT_VP = 21495808, OUT_CP = 25690112, OUT_HP = 25696256,
                 OUT_KS = 25698304, OUT_VS = 25960448, OUT_CS = 26222592, OUT_HS = 26419200, OUT_END = 26484736;
constexpr size_t MiB = 1u << 20;
constexpr size_t WS_CTL = 0, CTL_ZERO_BYTES = 1 * MiB;
constexpr size_t WS_WIN = 2 * MiB, WS_WOUT = 8 * MiB;
constexpr size_t WS_WG = 10 * MiB, WS_SP8 = 11 * MiB;
constexpr size_t WS_XB = 16 * MiB;
constexpr size_t WS_Q = 64 * MiB, WS_K = 81 * MiB, WS_V = 98 * MiB, WS_GA = 115 * MiB, WS_XL = 132 * MiB, WS_GL = 149 * MiB;
constexpr size_t WS_O0 = 176 * MiB, WS_O1 = 192 * MiB, WS_O2 = 208 * MiB;
constexpr size_t WS_ML = 224 * MiB;
constexpr size_t WS_HL = 232 * MiB, WS_PP = 248 * MiB;
constexpr size_t WS_SUM = 264 * MiB;
constexpr size_t WS_Q2F = 266 * MiB;
constexpr size_t WS_PARTO = 267 * MiB, WS_PARTM = 270 * MiB;
constexpr size_t WS_MIX = 272 * MiB;
constexpr size_t WS_Z = 320 * MiB;
constexpr size_t WS_END = 392 * MiB;
constexpr int CW_BAR = 4096, CW_QHEAD = 1024;
constexpr int PHASE_BYTES = 133120;
constexpr int MISC_OFF = PHASE_BYTES, WSCR_OFF = MISC_OFF + 256, LDS_BYTES = 147456;
static_assert(WSCR_OFF + NWAVES * 256 <= LDS_BYTES, "LDS map");

typedef unsigned u32x2 __attribute__((ext_vector_type(2)));
typedef float f32x2 __attribute__((ext_vector_type(2)));
typedef float f32x16 __attribute__((ext_vector_type(16)));
typedef short s16x4 __attribute__((ext_vector_type(4)));

__device__ __forceinline__ float bflo(unsigned w) { return __uint_as_float(w << 16); }
__device__ __forceinline__ float bfhi(unsigned w) { return __uint_as_float(w & 0xffff0000u); }
__device__ __forceinline__ float fast_exp2(float x) { return __builtin_amdgcn_exp2f(x); }
__device__ __forceinline__ float sigmoidf_(float x) { return __builtin_amdgcn_rcpf(1.0f + fast_exp2(-x * LOG2E)); }
__device__ __forceinline__ float siluf_(float x) { return x * sigmoidf_(x); }
__device__ __forceinline__ float wave_sum(float v) {
#pragma unroll
    for (int o = 1; o < 64; o <<= 1) v += __shfl_xor(v, o);
    return v;
}

struct EpiProj {
    static constexpr bool PERM = true, AFTER_DRAIN = false;
    bf16 *Qb, *Kb, *Vb, *GAb, *XLb, *GLb; float* Q2f; float* out;
    __device__ __forceinline__ void operator()(const f32x4 (&acc)[2][2][4][2], const pg8::Unit& u, int wr, int wc, int fr, int fq) const {
        const int kind = u.pn >> 1;
        const int cs0 = (u.pn & 1) * 256 + wc * 32 + 8 * fq;
        const int rowt = u.pm * 256 + wr * 64 + fr;
        const bool samp = u.pm >= (MP / 256);
        bf16* dstb = kind == 0 ? Qb : kind == 1 ? Kb : kind == 2 ? Vb : kind == 3 ? GAb : kind == 4 ? XLb : GLb;
#pragma unroll
        for (int ai = 0; ai < 2; ++ai)
#pragma unroll
            for (int m = 0; m < 4; ++m) {
                const int row = rowt + ai * 128 + m * 16;
                float* fo = nullptr;
                if (kind == 1 || kind == 2) {
                    if (!samp) { const int t = row & (SEQ - 1), b = row >> 12; if (t >= SEQ - WBUF) fo = out + (kind == 1 ? OUT_KP : OUT_VP) + (size_t)(b * WBUF + t - (SEQ - WBUF)) * DH; }
                    else fo = out + (kind == 1 ? OUT_KS : OUT_VS) + (size_t)(row - MP) * DH;
                } else if (kind == 4) {
                    if (!samp) { const int t = row & (SEQ - 1), b = row >> 12; if (t >= SEQ - 3) fo = out + OUT_CP + (size_t)(b * 3 + t - (SEQ - 3)) * DH; }
                    else { const int rs = row - MP, ts = rs & 3; if (ts >= 1) fo = out + OUT_CS + (size_t)((rs >> 2) * 3 + ts - 1) * DH; }
                } else if (kind == 0 && samp) fo = Q2f + (size_t)(row - MP) * DH;
#pragma unroll
                for (int bj = 0; bj < 2; ++bj) {
                    f32x4 v0 = acc[ai][bj][m][0], v1 = acc[ai][bj][m][1];
                    const int cs = cs0 + bj * 128;
                    if (kind == 0) { v0 = v0 * QSCALE; v1 = v1 * QSCALE; }
                    if (kind == 3 || kind == 5) {
#pragma unroll
                        for (int e = 0; e < 4; ++e) { v0[e] = siluf_(v0[e]); v1[e] = siluf_(v1[e]); }
                    }
                    if (fo) { *(f32x4*)(fo + cs) = v0; *(f32x4*)(fo + cs + 4) = v1; }
                    pg8::u32x4 w; w.x = pg8::cvt_pk_bf16(v0[0], v0[1]); w.y = pg8::cvt_pk_bf16(v0[2], v0[3]); w.z = pg8::cvt_pk_bf16(v1[0], v1[1]); w.w = pg8::cvt_pk_bf16(v1[2], v1[3]);
                    *(pg8::u32x4*)(dstb + (size_t)row * DH + cs) = w;
                }
            }
    }
};
struct EpiZ {
    static constexpr bool PERM = false, AFTER_DRAIN = false;
    const float* xp; const float* xs; float* Z;
    __device__ __forceinline__ void operator()(const f32x4 (&acc)[2][2][4][2], const pg8::Unit& u, int wr, int wc, int fr, int fq) const {
        const int col0 = u.pn * 256 + wc * 32 + 4 * fq;
#pragma unroll
        for (int ai = 0; ai < 2; ++ai)
#pragma unroll
            for (int m = 0; m < 4; ++m) {
                const int row = u.pm * 256 + ai * 128 + wr * 64 + m * 16 + fr;
                const float* xr = row < MP ? xp + (size_t)row * DM : xs + (size_t)(row - MP) * DM;
                float* zr = Z + (size_t)row * DM;
#pragma unroll
                for (int bj = 0; bj < 2; ++bj)
#pragma unroll
                    for (int n = 0; n < 2; ++n) { const int c = col0 + bj * 128 + n * 16; const f32x4 xv = *(const f32x4*)(xr + c); *(f32x4*)(zr + c) = xv * ALPHA + acc[ai][bj][m][n]; }
            }
    }
};

struct Frame {
    LAS unsigned char* lds;
    volatile LAS unsigned* MISC;
    gu32* ctl;
    int tid, lane, wave, G;
    const float *xp, *xs, *ck, *cv, *sconv, *sh, *w_in, *conv_w, *conv_b, *w_ra, *b_ra, *w_ri, *b_ri, *lam, *w_out, *ln_g, *ln_b;
    float* out;
    bf16 *WG; float* SP8;
    bf16 *WinT, *WoutT, *XB, *Qb, *Kb, *Vb, *GAb, *XLb, *GLb, *O0, *O1, *O2, *HL, *PP, *MIX;
    float *ML, *SUM, *Q2f, *Z, *PARTO, *PARTM;
};

__device__ __forceinline__ void p0_transpose_item(const float* W, int K, int N, bf16* WT, LAS float* scr, int item, int lane) {
    const int nblk = N / 32, kb = item / nblk, nb = item % nblk, k0 = 64 * kb, n0 = 32 * nb;
#pragma unroll 8
    for (int i = 0; i < 32; ++i) { const int kk = 2 * i + (lane >> 5); scr[kk * 33 + (lane & 31)] = W[(size_t)(k0 + kk) * N + n0 + (lane & 31)]; }
    LDS_WAIT(); asm volatile("" ::: "memory");
    const int c = lane & 7;
#pragma unroll
    for (int j = 0; j < 4; ++j) { const int n = (lane >> 3) + 8 * j; const LAS float* s = scr + (8 * c) * 33 + n;
        v4u o; o.x = pk2(s[0 * 33], s[1 * 33]); o.y = pk2(s[2 * 33], s[3 * 33]); o.z = pk2(s[4 * 33], s[5 * 33]); o.w = pk2(s[6 * 33], s[7 * 33]);
        *(GAS v4u*)(WT + (size_t)(n0 + n) * K + k0 + 8 * c) = o; }
    LDS_WAIT(); asm volatile("" ::: "memory");
}
__device__ __forceinline__ void p0_prologue(Frame& F) {
    LAS float* scr = (LAS float*)(F.lds + F.wave * 16384);
    const int gw = blockIdx.x * NWAVES + F.wave, NGW = F.G * NWAVES;
    constexpr int I_IN = (DM / 64) * (DIN / 32), I_OUT = (DM / 64) * (DM / 32);
    for (int it = gw; it < I_IN + I_OUT; it += NGW) {
        if (it < I_IN) p0_transpose_item(F.w_in, DM, DIN, F.WinT, scr, it, F.lane);
        else p0_transpose_item(F.w_out, DM, DM, F.WoutT, scr, it - I_IN, F.lane);
    }
    for (int i = blockIdx.x * (NWAVES * 64) + F.tid; i < 2 * 8 * 2 * 4 * 64; i += F.G * NWAVES * 64) {
        const int ln = i & 63, s = (i >> 6) & 3, mt = (i >> 8) & 1, g = (i >> 9) & 7, gate = i >> 12;
        const int m = ln & 31, hi = ln >> 5, rr = (m & 3) + 4 * (m >> 3), hp = (m >> 2) & 1, idx = 16 * mt + rr, oc = 16 * (idx >> 3) + 8 * hp + (idx & 7);
        const float* W = gate ? F.w_ri : F.w_ra;
        float a[8];
#pragma unroll
        for (int j = 0; j < 8; ++j) a[j] = W[(size_t)(g * 64 + 16 * s + 8 * hi + j) * 64 + oc];
        v4u o; o.x = pk2(a[0], a[1]); o.y = pk2(a[2], a[3]); o.z = pk2(a[4], a[5]); o.w = pk2(a[6], a[7]);
        *(v4u*)(F.WG + (size_t)i * 8) = o;
    }
    for (int i = blockIdx.x * (NWAVES * 64) + F.tid; i < DH; i += F.G * NWAVES * 64) F.SP8[i] = 8.0f * log1pf(expf(-F.lam[i]));
    constexpr size_t NCHK = (size_t)MT * DM / 8, PCHK = (size_t)MP * DM / 8;
    for (size_t i = (size_t)gw * 64 + F.lane; i < NCHK; i += (size_t)NGW * 64) {
        const float* src = i < PCHK ? F.xp + i * 8 : F.xs + (i - PCHK) * 8;
        const f32x4 a = *(const f32x4*)src, b = *(const f32x4*)(src + 4);
        v4u o; o.x = pg8::cvt_pk_bf16(a[0], a[1]); o.y = pg8::cvt_pk_bf16(a[2], a[3]); o.z = pg8::cvt_pk_bf16(b[0], b[1]); o.w = pg8::cvt_pk_bf16(b[2], b[3]);
        *(v4u*)(F.XB + i * 8) = o;
    }
}

constexpr int A_K = 0, A_V = 49152, A_STG = 98304;
__device__ __forceinline__ int crow(int r, int hi) { return (r & 3) + 8 * (r >> 2) + 4 * hi; }
__device__ __forceinline__ void attn_unit(Frame& F, const bf16* __restrict__ Q, const bf16* __restrict__ K, const bf16* __restrict__ V, bf16* __restrict__ O, float* __restrict__ ML,
                                          int d, int b, int h, int rc, int qb) {
    LAS unsigned char* L = F.lds;
    int tid_ = F.tid; asm volatile("" : "+v"(tid_));
    const int tid = tid_, lane = tid & 63, w = F.wave, q = lane & 31, hi = lane >> 5;
    const int i0 = qb * 256;
    const size_t rowb = (size_t)b * SEQ;
    {
        const int c = tid & 7, r0 = tid >> 3;
        v4u kr[6], vr[6];
#pragma unroll
        for (int ps = 0; ps < 6; ++ps) {
            const int row = ps * 64 + r0, i = i0 - 128 + row;
            if (i >= 0) { const size_t g = (rowb + (size_t)i * d + rc) * DH + h * HD + c * 8; kr[ps] = *(const v4u*)(K + g); vr[ps] = *(const v4u*)(V + g); }
            else { kr[ps] = (v4u){0u, 0u, 0u, 0u}; vr[ps] = (v4u){0u, 0u, 0u, 0u}; }
        }
#pragma unroll
        for (int ps = 0; ps < 6; ++ps) {
            const int row = ps * 64 + r0;
            *(LAS v4u*)(L + A_K + row * 128 + ((c ^ ((row >> 1) & 7)) << 4)) = kr[ps];
            *(LAS v4u*)(L + A_V + row * 128 + ((c ^ (((row >> 1) & 1) << 2)) << 4)) = vr[ps];
        }
    }
    const size_t qrow = rowb + (size_t)(i0 + 32 * w + q) * d + rc;
    bf16x8 qr[4];
#pragma unroll
    for (int s = 0; s < 4; ++s) qr[s] = *(const bf16x8*)(Q + qrow * DH + h * HD + 16 * s + 8 * hi);
    __syncthreads();
    f32x16 S[5];
#pragma unroll
    for (int kt = 0; kt < 5; ++kt) {
        const int krow = 32 * w + 32 * kt + q;
        f32x16 a = {};
#pragma unroll
        for (int s = 0; s < 4; ++s) {
            const bf16x8 kf = *(const LAS bf16x8*)(L + A_K + krow * 128 + (((2 * s + hi) ^ ((krow >> 1) & 7)) << 4));
            a = __builtin_amdgcn_mfma_f32_32x32x16_bf16(kf, qr[s], a, 0, 0, 0);
        }
        S[kt] = a;
    }
    const int kpos0 = i0 + 32 * w - 128;
    float mx = NEGBIG;
#pragma unroll
    for (int kt = 0; kt < 5; ++kt)
#pragma unroll
        for (int r = 0; r < 16; ++r) {
            const int kk = 32 * kt + crow(r, hi);
            const bool valid = (kk >= q) && (kk <= q + 128) && (kpos0 + kk >= 0);
            const float sv = valid ? S[kt][r] : NEGBIG;
            S[kt][r] = sv; mx = fmaxf(mx, sv);
        }
    mx = fmaxf(mx, __shfl_xor(mx, 32));
    float ls = 0.f;
#pragma unroll
    for (int kt = 0; kt < 5; ++kt)
#pragma unroll
        for (int r = 0; r < 16; ++r) { const float p = fast_exp2(S[kt][r] - mx); S[kt][r] = p; ls += p; }
    ls += __shfl_xor(ls, 32);
    f32x16 o[2]; o[0] = (f32x16){}; o[1] = (f32x16){};
    const int trq = (lane & 15) >> 2, trp = lane & 3, blk = (lane >> 4) & 1;
#pragma unroll
    for (int kt = 0; kt < 5; ++kt)
#pragma unroll
        for (int s2 = 0; s2 < 2; ++s2) {
            v4u pw; pw.x = pg8::cvt_pk_bf16(S[kt][8 * s2 + 0], S[kt][8 * s2 + 1]); pw.y = pg8::cvt_pk_bf16(S[kt][8 * s2 + 2], S[kt][8 * s2 + 3]);
            pw.z = pg8::cvt_pk_bf16(S[kt][8 * s2 + 4], S[kt][8 * s2 + 5]); pw.w = pg8::cvt_pk_bf16(S[kt][8 * s2 + 6], S[kt][8 * s2 + 7]);
            const bf16x8 pa = __builtin_bit_cast(bf16x8, pw);
#pragma unroll
            for (int c = 0; c < 2; ++c) {
                s16x4 vt[2];
#pragma unroll
                for (int t = 0; t < 2; ++t) {
                    const int row = 32 * w + 32 * kt + 16 * s2 + 8 * t + 4 * hi + trq;
                    const int chunk = 4 * c + 2 * blk + (trp >> 1);
                    vt[t] = __builtin_bit_cast(s16x4, __builtin_amdgcn_ds_read_tr16_b64_v4i16((LAS s16x4*)(L + A_V + row * 128 + ((chunk ^ (((row >> 1) & 1) << 2)) << 4) + 8 * (trp & 1))));
                }
                const bf16x8 vf = (bf16x8){vt[0][0], vt[0][1], vt[0][2], vt[0][3], vt[1][0], vt[1][1], vt[1][2], vt[1][3]};
                o[c] = __builtin_amdgcn_mfma_f32_32x32x16_bf16(pa, vf, o[c], 0, 0, 0);
            }
        }
    LAS float* wscr = (LAS float*)(L + WSCR_OFF + w * 256);
    if (hi == 0) { wscr[q] = ls; *(f32x2*)(ML + (qrow * NH + h) * 2) = (f32x2){mx, ls}; }
    LDS_WAIT(); asm volatile("" ::: "memory");
    LAS unsigned short* stg = (LAS unsigned short*)(L + A_STG + w * 4096);
#pragma unroll
    for (int r = 0; r < 16; ++r) {
        const int qo = crow(r, hi);
        const float li = __builtin_amdgcn_rcpf(wscr[qo]);
        stg[qo * 64 + q] = (unsigned short)f2bf(o[0][r] * li);
        stg[qo * 64 + 32 + q] = (unsigned short)f2bf(o[1][r] * li);
    }
    LDS_WAIT(); asm volatile("" ::: "memory");
#pragma unroll
    for (int i = 0; i < 4; ++i) {
        const int row = i * 8 + (lane >> 3), ch = lane & 7;
        const v4u v = *(const LAS v4u*)((LAS unsigned char*)stg + row * 128 + ch * 16);
        *(v4u*)(O + (rowb + (size_t)(i0 + 32 * w + row) * d + rc) * DH + h * HD + ch * 8) = v;
    }
    __syncthreads();
}

constexpr int SCAN_WAVE_BYTES = 2 * 32 * 65 * 4;
static_assert(NWAVES * SCAN_WAVE_BYTES <= PHASE_BYTES, "scan tiles");
__device__ __forceinline__ float neg_expm1(float x, float ex) {
    const float p = -x * (1.0f + x * (0.5f + x * (0.16666667f + x * (0.041666668f + x * (0.0083333338f + x * 0.0013888889f)))));
    return x > -0.25f ? p : 1.0f - ex;
}
__device__ __forceinline__ void lru_unit(Frame& F, int b, int c) {
    int lane_ = F.lane; asm volatile("" : "+v"(lane_));
    const int lane = lane_, g = F.wave, tl = lane & 31, hi = lane >> 5;
    LAS float* As = (LAS float*)(F.lds + g * SCAN_WAVE_BYTES);
    LAS float* Bs = As + 32 * 65;
    float hc = 0.f, pc = 1.f;
    const size_t rowb = (size_t)b * SEQ;
    for (int nt = 0; nt < 2; ++nt) {
        const int t = 64 * c + 32 * nt + tl;
        float u[32];
        bf16x8 ub[4];
#pragma unroll
        for (int s = 0; s < 4; ++s) {
            const int ch0 = 64 * g + 16 * s + 8 * hi;
            float acc8[8];
            { const f32x4 c0 = *(const f32x4*)(F.conv_b + ch0), c1 = *(const f32x4*)(F.conv_b + ch0 + 4);
              acc8[0] = c0[0]; acc8[1] = c0[1]; acc8[2] = c0[2]; acc8[3] = c0[3]; acc8[4] = c1[0]; acc8[5] = c1[1]; acc8[6] = c1[2]; acc8[7] = c1[3]; }
#pragma unroll
            for (int wv = 0; wv < 4; ++wv) {
                const int tt = t - 3 + wv;
                v4u xw = (v4u){0u, 0u, 0u, 0u};
                if (tt >= 0) xw = *(const v4u*)(F.XLb + (rowb + tt) * DH + ch0);
                const f32x4 w0 = *(const f32x4*)(F.conv_w + wv * DH + ch0), w1 = *(const f32x4*)(F.conv_w + wv * DH + ch0 + 4);
                acc8[0] += w0[0] * bflo(xw.x); acc8[1] += w0[1] * bfhi(xw.x); acc8[2] += w0[2] * bflo(xw.y); acc8[3] += w0[3] * bfhi(xw.y);
                acc8[4] += w1[0] * bflo(xw.z); acc8[5] += w1[1] * bfhi(xw.z); acc8[6] += w1[2] * bflo(xw.w); acc8[7] += w1[3] * bfhi(xw.w);
            }
#pragma unroll
            for (int j = 0; j < 8; ++j) u[8 * s + j] = acc8[j];
            v4u pk; pk.x = pg8::cvt_pk_bf16(acc8[0], acc8[1]); pk.y = pg8::cvt_pk_bf16(acc8[2], acc8[3]); pk.z = pg8::cvt_pk_bf16(acc8[4], acc8[5]); pk.w = pg8::cvt_pk_bf16(acc8[6], acc8[7]);
            ub[s] = __builtin_bit_cast(bf16x8, pk);
        }
        f32x16 aR[2], aI[2];
#pragma unroll
        for (int mt = 0; mt < 2; ++mt) {
            f32x16 x = {}, y = {};
#pragma unroll
            for (int s = 0; s < 4; ++s) {
                const bf16x8 wr_ = *(const bf16x8*)(F.WG + ((size_t)(((0 * 8 + g) * 2 + mt) * 4 + s) * 64 + lane) * 8);
                const bf16x8 wi_ = *(const bf16x8*)(F.WG + ((size_t)(((1 * 8 + g) * 2 + mt) * 4 + s) * 64 + lane) * 8);
                x = __builtin_amdgcn_mfma_f32_32x32x16_bf16(wr_, ub[s], x, 0, 0, 0); y = __builtin_amdgcn_mfma_f32_32x32x16_bf16(wi_, ub[s], y, 0, 0, 0);
            }
            aR[mt] = x; aI[mt] = y;
        }
#pragma unroll
        for (int s = 0; s < 4; ++s) {
            const int ch0 = 64 * g + 16 * s + 8 * hi;
            float bra[8], bri[8], sp[8];
            { const f32x4 a0 = *(const f32x4*)(F.b_ra + ch0), a1 = *(const f32x4*)(F.b_ra + ch0 + 4), b0 = *(const f32x4*)(F.b_ri + ch0), b1 = *(const f32x4*)(F.b_ri + ch0 + 4),
                          l0 = *(const f32x4*)(F.SP8 + ch0), l1 = *(const f32x4*)(F.SP8 + ch0 + 4);
#pragma unroll
              for (int e = 0; e < 4; ++e) { bra[e] = a0[e]; bra[4 + e] = a1[e]; bri[e] = b0[e]; bri[4 + e] = b1[e]; sp[e] = l0[e]; sp[4 + e] = l1[e]; } }
#pragma unroll
            for (int j = 0; j < 8; ++j) {
                const int idx = 8 * s + j, mt = idx >> 4, r = idx & 15;
                const float xr = aR[mt][r] + bra[j], xi = aI[mt][r] + bri[j];
                const float rg = sigmoidf_(xr), ig = sigmoidf_(xi);
                const float la = -rg * sp[j];
                const float a = fast_exp2(la * LOG2E);
                const float mult = sqrtf(neg_expm1(2.0f * la, a * a));
                const float bx = mult * ig * u[idx];
                const int cl = 16 * s + 8 * hi + j;
                As[tl * 65 + cl] = a; Bs[tl * 65 + cl] = bx;
            }
        }
        LDS_WAIT(); asm volatile("" ::: "memory");
        {
            bf16* hl = F.HL + (rowb + 64 * c + 32 * nt) * DH + 64 * g + lane;
            bf16* pp = F.PP + (rowb + 64 * c + 32 * nt) * DH + 64 * g + lane;
#pragma unroll 8
            for (int tt = 0; tt < 32; ++tt) {
                const float a = As[tt * 65 + lane], bx = Bs[tt * 65 + lane];
                hc = a * hc + bx; pc = pc * a;
                hl[(size_t)tt * DH] = (bf16)f2bf(hc); pp[(size_t)tt * DH] = (bf16)f2bf(pc);
            }
        }
        LDS_WAIT(); asm volatile("" ::: "memory");
    }
    *(f32x2*)(F.SUM + ((size_t)(b * NCH + c) * DH + 64 * g + lane) * 2) = (f32x2){pc, hc};
}

#define DPP_ADD(v, ctrl) ((v) + __builtin_bit_cast(float, __builtin_amdgcn_update_dpp(0, __builtin_bit_cast(int, (v)), (ctrl), 0xF, 0xF, true)))
__device__ __forceinline__ float red16(float v) {
    v = DPP_ADD(v, 0xB1);
    v = DPP_ADD(v, 0x4E);
    v = DPP_ADD(v, 0x141);
    v = DPP_ADD(v, 0x140);
    return v;
}
struct SmpSt { f32x4 qA, qB, aA, aB; float mA, mB, lA, lB; };
struct SmpBuf { f32x4 kA[4], kB[4], vA[4], vB[4]; };
__device__ __forceinline__ f32x4 ntload4(const float* p) { return __builtin_nontemporal_load((const f32x4*)p); }
__device__ __forceinline__ void smp_chunk(SmpSt& S, const SmpBuf& B, const float (&wgt)[4]) {
    float sA[4], sB[4];
#pragma unroll
    for (int e = 0; e < 4; ++e) {
        float a = S.qA[0] * B.kA[e][0] + S.qA[1] * B.kA[e][1] + S.qA[2] * B.kA[e][2] + S.qA[3] * B.kA[e][3];
        float b = S.qB[0] * B.kB[e][0] + S.qB[1] * B.kB[e][1] + S.qB[2] * B.kB[e][2] + S.qB[3] * B.kB[e][3];
        a = red16(a); b = red16(b);
        sA[e] = wgt[e] > 0.f ? a : NEGBIG; sB[e] = wgt[e] > 0.f ? b : NEGBIG;
    }
    {
        const float mn = fmaxf(fmaxf(fmaxf(sA[0], sA[1]), fmaxf(sA[2], sA[3])), S.mA), sc = fast_exp2(S.mA - mn);
        float ps = 0.f; f32x4 acc = S.aA * sc;
#pragma unroll
        for (int e = 0; e < 4; ++e) { const float p = wgt[e] * fast_exp2(sA[e] - mn); ps += p; acc = acc + B.vA[e] * p; }
        S.lA = S.lA * sc + ps; S.aA = acc; S.mA = mn;
    }
    {
        const float mn = fmaxf(fmaxf(fmaxf(sB[0], sB[1]), fmaxf(sB[2], sB[3])), S.mB), sc = fast_exp2(S.mB - mn);
        float ps = 0.f; f32x4 acc = S.aB * sc;
#pragma unroll
        for (int e = 0; e < 4; ++e) { const float p = wgt[e] * fast_exp2(sB[e] - mn); ps += p; acc = acc + B.vB[e] * p; }
        S.lB = S.lB * sc + ps; S.aB = acc; S.mB = mn;
    }
}
constexpr int SMP_ACC = 0, SMP_ML = 16384, SMP_U = 16384 + 512;
__device__ __forceinline__ void sample_unit(Frame& F, int bs, int half) {
    int tid_ = F.tid; asm volatile("" : "+v"(tid_));
    const int tid = tid_, lane = tid & 63, w = F.wave;
    LAS unsigned char* L = F.lds;
    const float* ck = F.ck + (size_t)bs * WBUF * DH;
    const float* cv = F.cv + (size_t)bs * WBUF * DH;
    const float* kn = F.out + OUT_KS + (size_t)bs * ST * DH;
    const float* vn = F.out + OUT_VS + (size_t)bs * ST * DH;
    const float* q2 = F.Q2f + (size_t)bs * ST * DH;
    const int lo = 4 * lane;
    const int ts = w & 3, sub = w >> 2, dd = half ? 16 : 4;
    SmpSt S;
    S.qA = *(const f32x4*)(q2 + ts * DH + lo); S.qB = *(const f32x4*)(q2 + ts * DH + 256 + lo);
    S.aA = (f32x4){0.f, 0.f, 0.f, 0.f}; S.aB = S.aA; S.mA = NEGBIG; S.mB = NEGBIG; S.lA = 0.f; S.lB = 0.f;
    const int rbase = half ? (WBUF - 128) : (WBUF - 64);
#define SMP_ROW(k) ((k) < 128 ? (WBUF + ts - dd * ((k) + 1)) : (rbase + (k) - 128))
#define SMP_LOAD(BUF, k0) do { _Pragma("unroll") for (int e_ = 0; e_ < 4; ++e_) { const size_t ro_ = (size_t)SMP_ROW((k0) + e_) * DH + lo; \
        BUF.kA[e_] = ntload4(ck + ro_); BUF.kB[e_] = ntload4(ck + ro_ + 256); BUF.vA[e_] = ntload4(cv + ro_); BUF.vB[e_] = ntload4(cv + ro_ + 256); } } while (0)
    SmpBuf b0, b1;
    const int k0 = 96 * sub;
    SMP_LOAD(b0, k0);
    if (sub == 0) {
        SmpBuf bn; float wn[4];
#pragma unroll
        for (int e = 0; e < 4; ++e) { const float* kp = kn + e * DH + lo; const float* vp = vn + e * DH + lo;
            bn.kA[e] = *(const f32x4*)kp; bn.kB[e] = *(const f32x4*)(kp + 256); bn.vA[e] = *(const f32x4*)vp; bn.vB[e] = *(const f32x4*)(vp + 256);
            wn[e] = (e == ts ? 1.f : 0.f) + ((half == 0 && e <= ts) ? 1.f : 0.f); }
        smp_chunk(S, bn, wn);
    }
    const float w1[4] = {1.f, 1.f, 1.f, 1.f};
    for (int k = k0; k < k0 + 96; k += 8) {
        SMP_LOAD(b1, k + 4);
        if (k == 128 && half == 1) { const float wq[4] = {0 >= ts ? 1.f : 0.f, 1 >= ts ? 1.f : 0.f, 2 >= ts ? 1.f : 0.f, 1.f}; smp_chunk(S, b0, wq); }
        else smp_chunk(S, b0, w1);
        if (k + 8 < k0 + 96) SMP_LOAD(b0, k + 8);
        smp_chunk(S, b1, w1);
    }
#undef SMP_ROW
#undef SMP_LOAD
    {
        LAS float* pa = (LAS float*)(L + SMP_ACC) + w * 512;
        LAS float* pm = (LAS float*)(L + SMP_ML) + w * 16;
        *(LAS f32x4*)(pa + lo) = S.aA; *(LAS f32x4*)(pa + 256 + lo) = S.aB;
        if ((lane & 15) == 0) { const int hA = lane >> 4; pm[hA * 2] = S.mA; pm[hA * 2 + 1] = S.lA; pm[(4 + hA) * 2] = S.mB; pm[(4 + hA) * 2 + 1] = S.lB; }
    }
    __syncthreads();
    {
        const int hd = tid >> 6;
        const LAS float* pm = (const LAS float*)(L + SMP_ML);
        const LAS float* pa = (const LAS float*)(L + SMP_ACC);
#pragma unroll
        for (int t = 0; t < 4; ++t) {
            const float m0 = pm[t * 16 + hd * 2], l0 = pm[t * 16 + hd * 2 + 1], m1 = pm[(t + 4) * 16 + hd * 2], l1 = pm[(t + 4) * 16 + hd * 2 + 1];
            const float M = fmaxf(m0, m1), s0 = fast_exp2(m0 - M), s1 = fast_exp2(m1 - M);
            const size_t pi = (size_t)(bs * 2 + half) * 4 + t;
            F.PARTO[pi * DH + tid] = pa[t * 512 + tid] * s0 + pa[(t + 4) * 512 + tid] * s1;
            if ((tid & 63) == 0) *(f32x2*)(F.PARTM + (pi * NH + hd) * 2) = (f32x2){M, l0 * s0 + l1 * s1};
        }
    }
    __syncthreads();
}
__device__ __forceinline__ void sample_finish(Frame& F, int bs) {
    int tid_ = F.tid; asm volatile("" : "+v"(tid_));
    const int tid = tid_;
    LAS unsigned char* L = F.lds;
    const int ch = tid, g = ch >> 6, oc = ch & 63;
    float uu[4];
    {
        float xc[7];
#pragma unroll
        for (int i = 0; i < 3; ++i) xc[i] = F.sconv[(size_t)(bs * 3 + i) * DH + ch];
#pragma unroll
        for (int t = 0; t < 4; ++t) xc[3 + t] = __uint_as_float((unsigned)F.XLb[(size_t)(MP + bs * ST + t) * DH + ch] << 16);
        const float cb = F.conv_b[ch];
        float cw[4];
#pragma unroll
        for (int wv = 0; wv < 4; ++wv) cw[wv] = F.conv_w[wv * DH + ch];
#pragma unroll
        for (int t = 0; t < 4; ++t) { uu[t] = cb + cw[0] * xc[t] + cw[1] * xc[t + 1] + cw[2] * xc[t + 2] + cw[3] * xc[t + 3]; ((LAS float*)(L + SMP_U))[t * 512 + ch] = uu[t]; }
    }
    __syncthreads();
    {
        const int hd = tid >> 6;
#pragma unroll
        for (int t = 0; t < 4; ++t) {
            const size_t p0 = (size_t)(bs * 2 + 0) * 4 + t, p1 = (size_t)(bs * 2 + 1) * 4 + t;
            const f32x2 ml0 = *(const f32x2*)(F.PARTM + (p0 * NH + hd) * 2), ml1 = *(const f32x2*)(F.PARTM + (p1 * NH + hd) * 2);
            const float M = fmaxf(ml0.x, ml1.x), s0 = fast_exp2(ml0.x - M), s1 = fast_exp2(ml1.x - M);
            const float Ls = ml0.y * s0 + ml1.y * s1, Os = F.PARTO[p0 * DH + tid] * s0 + F.PARTO[p1 * DH + tid] * s1;
            const size_t row = (size_t)MP + bs * ST + t;
            const float gate = __uint_as_float((unsigned)F.GAb[row * DH + tid] << 16);
            F.MIX[row * DM + tid] = (bf16)f2bf(Os / Ls * gate);
        }
    }
    {
        float xr[4], xi[4];
        const float bra = F.b_ra[ch], bri = F.b_ri[ch];
#pragma unroll
        for (int t = 0; t < 4; ++t) { xr[t] = bra; xi[t] = bri; }
        const float* wra = F.w_ra + (size_t)g * 4096 + oc; const float* wri = F.w_ri + (size_t)g * 4096 + oc;
        const LAS float* us = (const LAS float*)(L + SMP_U) + 64 * g;
#pragma unroll 8
        for (int i = 0; i < 64; ++i) { const float a = wra[i * 64], bq = wri[i * 64];
#pragma unroll
            for (int t = 0; t < 4; ++t) { const float x = us[t * 512 + i]; xr[t] += x * a; xi[t] += x * bq; } }
        float hcur = F.sh[(size_t)bs * DH + ch];
        const float sp = F.SP8[ch];
#pragma unroll
        for (int t = 0; t < 4; ++t) {
            const float rg = sigmoidf_(xr[t]), ig = sigmoidf_(xi[t]);
            const float la = -rg * sp, a = fast_exp2(la * LOG2E), mult = sqrtf(neg_expm1(2.0f * la, a * a));
            hcur = a * hcur + mult * ig * uu[t];
            const size_t row = (size_t)MP + bs * ST + t;
            const float gate = __uint_as_float((unsigned)F.GLb[row * DH + ch] << 16);
            F.MIX[row * DM + DH + ch] = (bf16)f2bf(hcur * gate);
        }
        F.out[OUT_HS + (size_t)bs * DH + ch] = hcur;
    }
    __syncthreads();
}

__device__ __forceinline__ void mix_unit(Frame& F, int b, int c) {
    int tid_ = F.tid; asm volatile("" : "+v"(tid_));
    const int tid = tid_;
    LAS float* cs = (LAS float*)F.lds;
    {
        float carry = 0.f;
        const f32x2* sp = (const f32x2*)F.SUM + (size_t)b * NCH * DH + tid;
        for (int cc = 0; cc < c; ++cc) { const f32x2 ab = sp[(size_t)cc * DH]; carry = ab.x * carry + ab.y; }
        cs[tid] = carry;
        if (c == NCH - 1) { const f32x2 ab = sp[(size_t)c * DH]; F.out[OUT_HP + (size_t)b * DH + tid] = ab.x * carry + ab.y; }
    }
    __syncthreads();
    const int chunk = tid & 63, rsub = tid >> 6, col = chunk * 8, hd = chunk >> 3;
    for (int ps = 0; ps < 8; ++ps) {
        const size_t grow = (size_t)b * SEQ + 64 * c + ps * 8 + rsub;
        {
            const f32x2 ml0 = *(const f32x2*)(F.ML + ((0 * (size_t)MP + grow) * NH + hd) * 2), ml1 = *(const f32x2*)(F.ML + ((1 * (size_t)MP + grow) * NH + hd) * 2), ml2 = *(const f32x2*)(F.ML + ((2 * (size_t)MP + grow) * NH + hd) * 2);
            const float M = fmaxf(fmaxf(ml0.x, ml1.x), ml2.x);
            float w0 = ml0.y * fast_exp2(ml0.x - M), w1 = ml1.y * fast_exp2(ml1.x - M), w2 = ml2.y * fast_exp2(ml2.x - M);
            const float inv = 1.0f / (w0 + w1 + w2); w0 *= inv; w1 *= inv; w2 *= inv;
            const v4u a = *(const v4u*)(F.O0 + grow * DH + col), bq = *(const v4u*)(F.O1 + grow * DH + col), cq = *(const v4u*)(F.O2 + grow * DH + col), gt = *(const v4u*)(F.GAb + grow * DH + col);
            v4u o;
            o.x = pg8::cvt_pk_bf16((w0 * bflo(a.x) + w1 * bflo(bq.x) + w2 * bflo(cq.x)) * bflo(gt.x), (w0 * bfhi(a.x) + w1 * bfhi(bq.x) + w2 * bfhi(cq.x)) * bfhi(gt.x));
            o.y = pg8::cvt_pk_bf16((w0 * bflo(a.y) + w1 * bflo(bq.y) + w2 * bflo(cq.y)) * bflo(gt.y), (w0 * bfhi(a.y) + w1 * bfhi(bq.y) + w2 * bfhi(cq.y)) * bfhi(gt.y));
            o.z = pg8::cvt_pk_bf16((w0 * bflo(a.z) + w1 * bflo(bq.z) + w2 * bflo(cq.z)) * bflo(gt.z), (w0 * bfhi(a.z) + w1 * bfhi(bq.z) + w2 * bfhi(cq.z)) * bfhi(gt.z));
            o.w = pg8::cvt_pk_bf16((w0 * bflo(a.w) + w1 * bflo(bq.w) + w2 * bflo(cq.w)) * bflo(gt.w), (w0 * bfhi(a.w) + w1 * bfhi(bq.w) + w2 * bfhi(cq.w)) * bfhi(gt.w));
            *(v4u*)(F.MIX + grow * DM + col) = o;
        }
        {
            const v4u hl = *(const v4u*)(F.HL + grow * DH + col), pp = *(const v4u*)(F.PP + grow * DH + col), gt = *(const v4u*)(F.GLb + grow * DH + col);
            const f32x4 c0 = *(const LAS f32x4*)(cs + col), c1 = *(const LAS f32x4*)(cs + col + 4);
            v4u o;
            o.x = pg8::cvt_pk_bf16((bflo(hl.x) + bflo(pp.x) * c0[0]) * bflo(gt.x), (bfhi(hl.x) + bfhi(pp.x) * c0[1]) * bfhi(gt.x));
            o.y = pg8::cvt_pk_bf16((bflo(hl.y) + bflo(pp.y) * c0[2]) * bflo(gt.y), (bfhi(hl.y) + bfhi(pp.y) * c0[3]) * bfhi(gt.y));
            o.z = pg8::cvt_pk_bf16((bflo(hl.z) + bflo(pp.z) * c1[0]) * bflo(gt.z), (bfhi(hl.z) + bfhi(pp.z) * c1[1]) * bfhi(gt.z));
            o.w = pg8::cvt_pk_bf16((bflo(hl.w) + bflo(pp.w) * c1[2]) * bflo(gt.w), (bfhi(hl.w) + bfhi(pp.w) * c1[3]) * bfhi(gt.w));
            *(v4u*)(F.MIX + grow * DM + DH + col) = o;
        }
    }
    __syncthreads();
}

__device__ __forceinline__ void ln_row(Frame& F, int row) {
    const f32x4* zr = (const f32x4*)(F.Z + (size_t)row * DM) + F.lane;
    f32x4 v[4]; float s = 0.f;
#pragma unroll
    for (int j = 0; j < 4; ++j) { v[j] = zr[64 * j]; s += (v[j][0] + v[j][1]) + (v[j][2] + v[j][3]); }
    const float mean = wave_sum(s) * (1.f / DM); float s2 = 0.f;
#pragma unroll
    for (int j = 0; j < 4; ++j) { v[j] = v[j] - mean; s2 += (v[j][0] * v[j][0] + v[j][1] * v[j][1]) + (v[j][2] * v[j][2] + v[j][3] * v[j][3]); }
    const float rstd = 1.f / sqrtf(wave_sum(s2) * (1.f / DM) + LN_EPS);
    float* orow = row < MP ? F.out + OUT_YP + (size_t)row * DM : F.out + OUT_YS + (size_t)(row - MP) * DM;
#pragma unroll
    for (int j = 0; j < 4; ++j) { const f32x4 g = ((const f32x4*)F.ln_g)[F.lane + 64 * j], bb = ((const f32x4*)F.ln_b)[F.lane + 64 * j]; ((f32x4*)orow)[F.lane + 64 * j] = v[j] * rstd * g + bb; }
}

struct Args { const float* in[17]; float* out; unsigned char* ws; };
__global__ void __launch_bounds__(NWAVES * 64, 2) mk_fwd(Args args) {
    extern __shared__ __attribute__((aligned(16))) unsigned char lds[];
    Frame F;
    F.lds = (LAS unsigned char*)lds;
    F.MISC = (volatile LAS unsigned*)(F.lds + MISC_OFF);
    F.tid = threadIdx.x; F.lane = F.tid & 63; F.wave = __builtin_amdgcn_readfirstlane(F.tid >> 6); F.G = gridDim.x;
    unsigned char* ws = args.ws;
    F.ctl = (gu32*)(ws + WS_CTL);
    F.xp = args.in[0]; F.xs = args.in[1]; F.ck = args.in[2]; F.cv = args.in[3]; F.sconv = args.in[4]; F.sh = args.in[5]; F.w_in = args.in[6]; F.conv_w = args.in[7]; F.conv_b = args.in[8];
    F.w_ra = args.in[9]; F.b_ra = args.in[10]; F.w_ri = args.in[11]; F.b_ri = args.in[12]; F.lam = args.in[13]; F.w_out = args.in[14]; F.ln_g = args.in[15]; F.ln_b = args.in[16];
    F.out = args.out;
    F.WG = (bf16*)(ws + WS_WG); F.SP8 = (float*)(ws + WS_SP8);
    F.WinT = (bf16*)(ws + WS_WIN); F.WoutT = (bf16*)(ws + WS_WOUT); F.XB = (bf16*)(ws + WS_XB);
    F.Qb = (bf16*)(ws + WS_Q); F.Kb = (bf16*)(ws + WS_K); F.Vb = (bf16*)(ws + WS_V); F.GAb = (bf16*)(ws + WS_GA); F.XLb = (bf16*)(ws + WS_XL); F.GLb = (bf16*)(ws + WS_GL);
    F.O0 = (bf16*)(ws + WS_O0); F.O1 = (bf16*)(ws + WS_O1); F.O2 = (bf16*)(ws + WS_O2); F.ML = (float*)(ws + WS_ML);
    F.HL = (bf16*)(ws + WS_HL); F.PP = (bf16*)(ws + WS_PP); F.SUM = (float*)(ws + WS_SUM); F.Q2f = (float*)(ws + WS_Q2F); F.MIX = (bf16*)(ws + WS_MIX); F.Z = (float*)(ws + WS_Z); F.PARTO = (float*)(ws + WS_PARTO); F.PARTM = (float*)(ws + WS_PARTM);
    for (int u = F.tid; u < (LDS_BYTES - MISC_OFF) / 4; u += NWAVES * 64) ((LAS unsigned*)(F.lds + MISC_OFF))[u] = 0u;
    __syncthreads();
    XcdBarrier bar = xcd_barrier_post((unsigned*)(F.ctl + CW_BAR), F.MISC + 8);
    const int bid = blockIdx.x, G = F.G;

#ifndef NO_P0
    for (int rep_ = 0; rep_ < REP_P0; ++rep_) p0_prologue(F);
#endif
    xcd_barrier(bar);

#ifndef NO_P1
    for (int rep_ = 0; rep_ < REP_P1; ++rep_) {
        pg8::Gemm g{F.XB, F.WinT, MT, DIN, DM}; pg8::StaticOrder S; S.init(MT, DIN, G, bid);
        EpiProj E{F.Qb, F.Kb, F.Vb, F.GAb, F.XLb, F.GLb, F.Q2f, F.out};
        pg8::gemm_phase<EpiProj, pg8::StaticOrder, true, true>(F.lds, g, S, E);
    }
#endif
    xcd_barrier(bar);

    for (int rep_ = 0; rep_ < REP_LRU; ++rep_)
    for (int u = bid; u < NB * NCH; u += G) lru_unit(F, u / NCH, u % NCH);
    __syncthreads();
    for (int rep_ = 0; rep_ < REP_SMP; ++rep_)
    for (int u = bid; u < 2 * SB; u += G) sample_unit(F, u >> 1, u & 1);
    for (int rep_ = 0; rep_ < REP_ATT; ++rep_)
    for (int u = bid; u < 3 * 512; u += G) {
        const int pat = u >> 9, rem = u & 511, bh = rem >> 4, sub = rem & 15;
        const int d = pat == 0 ? 1 : pat == 1 ? 4 : 16, nqb = 16 / d;
        bf16* Od = pat == 0 ? F.O0 : pat == 1 ? F.O1 : F.O2;
        attn_unit(F, F.Qb, F.Kb, F.Vb, Od, F.ML + (size_t)pat * MP * NH * 2, d, bh >> 3, bh & 7, sub / nqb, sub % nqb);
    }
    xcd_barrier(bar);

    for (int u = bid; u < SB; u += G) sample_finish(F, u);
#ifndef NO_MIX
    for (int rep_ = 0; rep_ < REP_MIX; ++rep_)
    for (int u = bid; u < NB * NCH; u += G) mix_unit(F, u / NCH, u % NCH);
#endif
    xcd_barrier(bar);

#ifndef NO_P4
    for (int rep_ = 0; rep_ < REP_P4; ++rep_) {
        pg8::Gemm g{F.MIX, F.WoutT, MT, DM, DM}; pg8::StaticOrder S; S.init(MT, DM, G, bid);
        EpiZ E{F.xp, F.xs, F.Z};
        pg8::gemm_phase<EpiZ, pg8::StaticOrder, true, true>(F.lds, g, S, E);
    }
#endif
    xcd_barrier(bar);

    for (int rep_ = 0; rep_ < REP_LN; ++rep_)
    for (int row = bid * NWAVES + F.wave; row < MT; row += G * NWAVES) ln_row(F, row);
}

extern "C" void kernel_launch(void* const* d_in, const int* in_sizes, int n_in, void* d_out, int out_size, void* d_ws, size_t ws_size, hipStream_t stream) {
    static int grid = 0;
    if (grid == 0) {
        if (n_in != 17 || in_sizes[0] != MP * DM || (size_t)out_size != OUT_END || ws_size < WS_END) {
            fprintf(stderr, "kernel_launch: unexpected shapes (n_in %d, in0 %d, out %d, ws %zu); nothing launched\n", n_in, n_in > 0 ? in_sizes[0] : -1, out_size, ws_size); grid = -1; return; }
        int dev = 0, cus = 0, per_cu = 0;
        if (hipGetDevice(&dev) != hipSuccess || hipDeviceGetAttribute(&cus, hipDeviceAttributeMultiprocessorCount, dev) != hipSuccess) { grid = -1; return; }
        if (hipFuncSetAttribute((const void*)mk_fwd, hipFuncAttributeMaxDynamicSharedMemorySize, LDS_BYTES) != hipSuccess) { fprintf(stderr, "kernel_launch: hipFuncSetAttribute failed\n"); grid = -1; return; }
        if (hipOccupancyMaxActiveBlocksPerMultiprocessor(&per_cu, (const void*)mk_fwd, NWAVES * 64, LDS_BYTES) != hipSuccess || per_cu < 1)
            fprintf(stderr, "kernel_launch: note: occupancy query reports %d workgroups per CU\n", per_cu);
        (void)hipGetLastError();
        grid = cus;
    }
    if (grid < 0) return;
    if (hipMemsetAsync((char*)d_ws + WS_CTL, 0, CTL_ZERO_BYTES, stream) != hipSuccess) return;
    Args a{};
    for (int i = 0; i < 17; ++i) a.in[i] = (const float*)d_in[i];
    a.out = (float*)d_out; a.ws = (unsigned char*)d_ws;
    hipLaunchKernelGGL(mk_fwd, dim3(grid), dim3(NWAVES * 64), LDS_BYTES, stream, a);
}
```
